# Optimizing an MI355X kernel written in HIP

```python
import jax, jax.numpy as jnp
from jax import lax
import numpy as np

D_MODEL = 1024
BATCH = 8
SEQ = 4096
DEPTH = 4

N_MIXERS = 2
N_REC_LAYERS = (DEPTH + 1) // 2
N_ATT_LAYERS = DEPTH // 2

LRU_WIDTH = D_MODEL
LRU_HEADS = 8
LRU_BLOCK = LRU_WIDTH // LRU_HEADS
CONV_WIDTH = 4
LRU_C = 8.0

N_HEADS = 8
HEAD_DIM = D_MODEL // N_HEADS
ROPE_THETA = 10000.0
MOBA_BLOCK = 256
MOBA_TOPK = 3
MOBA_Q_CHUNK = 32

N_EXPERTS = 32
TOP_K = 4
D_FF = D_MODEL
SWIGLU_ALPHA = 1.702
SWIGLU_LIMIT = 7.0
MOE_ROW_BLOCK = 256

DEEPNORM_ALPHA = (2.0 * DEPTH) ** 0.25
DEEPNORM_BETA = (8.0 * DEPTH) ** -0.25
LN_EPS = 1e-5

kernel_name = "hybrid_rglru_moba_moe_deepnorm"


def _layer_norm(x, g, b):
    xf = x.astype(jnp.float32)
    mu = jnp.mean(xf, axis=-1, keepdims=True)
    xc = xf - mu
    var = jnp.mean(xc * xc, axis=-1, keepdims=True)
    y = xc * lax.rsqrt(var + LN_EPS)
    return (y * g.astype(jnp.float32) + b.astype(jnp.float32)).astype(x.dtype)


def _rope(t):
    s = t.shape[2]
    half = HEAD_DIM // 2
    inv_freq = ROPE_THETA ** (-jnp.arange(half, dtype=jnp.float32) * 2.0 / HEAD_DIM)
    ang = jnp.arange(s, dtype=jnp.float32)[:, None] * inv_freq[None, :]
    cos, sin = jnp.cos(ang), jnp.sin(ang)
    tf = t.astype(jnp.float32)
    t1, t2 = tf[..., :half], tf[..., half:]
    return jnp.concatenate([t1 * cos - t2 * sin, t2 * cos + t1 * sin], axis=-1).astype(t.dtype)


def _rg_lru_mixer(x, w_in, conv_w, conv_b, w_ga, b_ga, w_gx, b_gx, lam, w_out):
    b, s, _ = x.shape
    proj = x @ w_in
    gate_branch, rec = proj[..., :LRU_WIDTH], proj[..., LRU_WIDTH:]
    u = lax.conv_general_dilated(rec, conv_w[:, None, :], window_strides=(1,), padding=[(CONV_WIDTH - 1, 0)],
                                 dimension_numbers=('NWC', 'WIO', 'NWC'), feature_group_count=LRU_WIDTH) + conv_b
    ub = u.reshape(b, s, LRU_HEADS, LRU_BLOCK)
    gate_a = jax.nn.sigmoid(jnp.einsum('bshi,hij->bshj', ub, w_ga).reshape(b, s, LRU_WIDTH) + b_ga)
    gate_x = jax.nn.sigmoid(jnp.einsum('bshi,hij->bshj', ub, w_gx).reshape(b, s, LRU_WIDTH) + b_gx)
    log_a = LRU_C * gate_a.astype(jnp.float32) * jax.nn.log_sigmoid(lam.astype(jnp.float32))
    a = jnp.exp(log_a)
    mult = jnp.sqrt(-jnp.expm1(2.0 * log_a))
    mult = jnp.where(jnp.arange(s)[None, :, None] == 0, 1.0, mult)
    b_in = mult * (gate_x * u).astype(jnp.float32)

    def combine(left, right):
        a_l, b_l = left
        a_r, b_r = right
        return a_l * a_r, a_r * b_l + b_r

    _, h = lax.associative_scan(combine, (a, b_in), axis=1)
    y = h.astype(x.dtype) * jax.nn.gelu(gate_branch, approximate=True)
    return y @ w_out


def _moba_mixer(x, w_qkv, w_o):
    b, s, _ = x.shape
    qkv = (x @ w_qkv).reshape(b, s, 3, N_HEADS, HEAD_DIM)
    q = _rope(jnp.transpose(qkv[:, :, 0], (0, 2, 1, 3)))
    k = _rope(jnp.transpose(qkv[:, :, 1], (0, 2, 1, 3)))
    v = jnp.transpose(qkv[:, :, 2], (0, 2, 1, 3))
    nb = -(-s // MOBA_BLOCK)
    pad = nb * MOBA_BLOCK - s
    kp = jnp.pad(k, ((0, 0), (0, 0), (0, pad), (0, 0)))
    vp = jnp.pad(v, ((0, 0), (0, 0), (0, pad), (0, 0)))
    kblk = kp.reshape(b, N_HEADS, nb, MOBA_BLOCK, HEAD_DIM)
    vblk = vp.reshape(b, N_HEADS, nb, MOBA_BLOCK, HEAD_DIM)
    kmean = jnp.mean(kblk.astype(jnp.float32), axis=3)
    topk = min(MOBA_TOPK, nb)
    n_chunks = s // MOBA_Q_CHUNK
    scale = HEAD_DIM ** -0.5
    bi = jnp.arange(b)[:, None, None, None]
    hi = jnp.arange(N_HEADS)[None, :, None, None]

    def chunk_fn(ci):
        q0 = ci * MOBA_Q_CHUNK
        qc = lax.dynamic_slice_in_dim(q, q0, MOBA_Q_CHUNK, axis=2)
        qblk = q0 // MOBA_BLOCK
        qpos = q0 + jnp.arange(MOBA_Q_CHUNK)
        s_blk = jnp.einsum('bhqd,bhnd->bhqn', qc.astype(jnp.float32), kmean)
        s_blk = jnp.where(jnp.arange(nb) < qblk, s_blk, -jnp.inf)
        _, sel = lax.top_k(s_blk, topk)
        valid = jnp.arange(topk) < qblk
        k_sel = kblk[bi, hi, sel]
        v_sel = vblk[bi, hi, sel]
        s_sel = jnp.einsum('bhqd,bhqnjd->bhqnj', qc, k_sel).astype(jnp.float32) * scale
        s_sel = jnp.where(valid[:, None], s_sel, -jnp.inf).reshape(b, N_HEADS, MOBA_Q_CHUNK, topk * MOBA_BLOCK)
        k_own = lax.dynamic_slice_in_dim(kp, qblk * MOBA_BLOCK, MOBA_BLOCK, axis=2)
        v_own = lax.dynamic_slice_in_dim(vp, qblk * MOBA_BLOCK, MOBA_BLOCK, axis=2)
        s_own = jnp.einsum('bhqd,bhjd->bhqj', qc, k_own).astype(jnp.float32) * scale
        kpos = qblk * MOBA_BLOCK + jnp.arange(MOBA_BLOCK)
        s_own = jnp.where(kpos[None, :] <= qpos[:, None], s_own, -jnp.inf)
        p = jax.nn.softmax(jnp.concatenate([s_sel, s_own], axis=-1), axis=-1)
        p_sel = p[..., :topk * MOBA_BLOCK].reshape(b, N_HEADS, MOBA_Q_CHUNK, topk, MOBA_BLOCK).astype(v.dtype)
        p_own = p[..., topk * MOBA_BLOCK:].astype(v.dtype)
        return (jnp.einsum('bhqnj,bhqnjd->bhqd', p_sel, v_sel)
                + jnp.einsum('bhqj,bhjd->bhqd', p_own, v_own))

    o = lax.map(chunk_fn, jnp.arange(n_chunks))
    o = jnp.transpose(o, (1, 0, 3, 2, 4)).reshape(b, s, N_HEADS * HEAD_DIM)
    return o @ w_o


def _moe(x, w_router, b_router, w_gu, b_gu, w_down, b_down):
    b, s, d = x.shape
    t = b * s
    x2 = x.reshape(t, d)
    logits = (x2 @ w_router + b_router).astype(jnp.float32)
    top_val, top_idx = lax.top_k(logits, TOP_K)
    gates = jax.nn.softmax(top_val, axis=-1)
    tk = t * TOP_K
    flat_e = top_idx.reshape(tk)
    flat_tok = jnp.arange(tk) // TOP_K
    flat_g = gates.reshape(tk)
    order = jnp.argsort(flat_e)
    se = flat_e[order]
    counts = jnp.bincount(flat_e, length=N_EXPERTS)
    starts = jnp.cumsum(counts) - counts
    pcounts = ((counts + MOE_ROW_BLOCK - 1) // MOE_ROW_BLOCK) * MOE_ROW_BLOCK
    pends = jnp.cumsum(pcounts)
    pstarts = pends - pcounts
    dest = pstarts[se] + jnp.arange(tk) - starts[se]
    n_blocks = (tk + N_EXPERTS * (MOE_ROW_BLOCK - 1) + MOE_ROW_BLOCK - 1) // MOE_ROW_BLOCK
    p_rows = n_blocks * MOE_ROW_BLOCK
    row_tok = jnp.full((p_rows,), t, jnp.int32).at[dest].set(flat_tok[order])
    row_gate = jnp.zeros((p_rows,), jnp.float32).at[dest].set(flat_g[order])
    blk_expert = jnp.minimum(jnp.searchsorted(pends, jnp.arange(n_blocks) * MOE_ROW_BLOCK, side='right'), N_EXPERTS - 1)
    x_pad = jnp.concatenate([x2, jnp.zeros((1, d), x2.dtype)], axis=0)
    xb = x_pad[row_tok].reshape(n_blocks, MOE_ROW_BLOCK, d)

    def expert_block(args):
        xb_i, e = args
        gu = xb_i @ w_gu[e] + b_gu[e]
        g = jnp.minimum(gu[:, :D_FF], SWIGLU_LIMIT)
        u = jnp.clip(gu[:, D_FF:], -SWIGLU_LIMIT, SWIGLU_LIMIT)
        h = (u + 1.0) * (g * jax.nn.sigmoid(SWIGLU_ALPHA * g))
        return h @ w_down[e] + b_down[e]

    yb = lax.map(expert_block, (xb, blk_expert))
    y = yb.reshape(p_rows, d).astype(jnp.float32) * row_gate[:, None]
    out = jax.ops.segment_sum(y, row_tok, num_segments=t + 1)[:t]
    return out.astype(x.dtype).reshape(b, s, d)


def setup_inputs(seed: int = 0) -> dict:
    key = jax.random.key(seed)
    ks = jax.random.split(key, 24)
    f32 = jnp.float32

    def nrm(k, shape, sc):
        return jax.random.normal(k, shape, f32) * sc

    d, w = D_MODEL, LRU_WIDTH
    x = nrm(ks[0], (BATCH, SEQ, d), 1.0)
    ln1_g = 1.0 + nrm(ks[1], (DEPTH, d), 0.02)
    ln1_b = nrm(ks[2], (DEPTH, d), 0.02)
    ln2_g = 1.0 + nrm(ks[3], (DEPTH, d), 0.02)
    ln2_b = nrm(ks[4], (DEPTH, d), 0.02)
    w_in_rec = nrm(ks[5], (N_REC_LAYERS, d, 2 * w), d ** -0.5)
    conv_w = nrm(ks[6], (N_REC_LAYERS, CONV_WIDTH, w), CONV_WIDTH ** -0.5)
    conv_b = nrm(ks[7], (N_REC_LAYERS, w), 0.01)
    w_gate_a = nrm(ks[8], (N_REC_LAYERS, LRU_HEADS, LRU_BLOCK, LRU_BLOCK), LRU_BLOCK ** -0.5)
    b_gate_a = nrm(ks[9], (N_REC_LAYERS, w), 0.01)
    w_gate_x = nrm(ks[10], (N_REC_LAYERS, LRU_HEADS, LRU_BLOCK, LRU_BLOCK), LRU_BLOCK ** -0.5)
    b_gate_x = nrm(ks[11], (N_REC_LAYERS, w), 0.01)
    a0 = jax.random.uniform(ks[12], (N_REC_LAYERS, w), f32, 0.9, 0.999)
    lru_lambda = jnp.log(a0) - jnp.log1p(-a0)
    w_out_rec = nrm(ks[13], (N_REC_LAYERS, w, d), (w ** -0.5) * DEEPNORM_BETA)
    w_qk = nrm(ks[14], (N_ATT_LAYERS, d, 2 * d), d ** -0.5)
    w_v = nrm(ks[15], (N_ATT_LAYERS, d, d), (d ** -0.5) * DEEPNORM_BETA)
    w_qkv = jnp.concatenate([w_qk, w_v], axis=-1)
    w_o = nrm(ks[16], (N_ATT_LAYERS, d, d), (d ** -0.5) * DEEPNORM_BETA)
    w_router = nrm(ks[17], (DEPTH, d, N_EXPERTS), d ** -0.5)
    b_router = nrm(ks[18], (DEPTH, N_EXPERTS), 0.01)
    w_gu = nrm(ks[19], (DEPTH, N_EXPERTS, d, 2 * D_FF), d ** -0.5)
    b_gu = nrm(ks[20], (DEPTH, N_EXPERTS, 2 * D_FF), 0.01)
    w_down = nrm(ks[21], (DEPTH, N_EXPERTS, D_FF, d), (D_FF ** -0.5) * DEEPNORM_BETA)
    b_down = nrm(ks[22], (DEPTH, N_EXPERTS, d), 0.01)
    return {"x": x, "ln1_g": ln1_g, "ln1_b": ln1_b, "ln2_g": ln2_g, "ln2_b": ln2_b,
            "w_in_rec": w_in_rec, "conv_w": conv_w, "conv_b": conv_b,
            "w_gate_a": w_gate_a, "b_gate_a": b_gate_a, "w_gate_x": w_gate_x, "b_gate_x": b_gate_x,
            "lru_lambda": lru_lambda, "w_out_rec": w_out_rec, "w_qkv": w_qkv, "w_o": w_o,
            "w_router": w_router, "b_router": b_router, "w_gu": w_gu, "b_gu": b_gu,
            "w_down": w_down, "b_down": b_down}


def reference(x, ln1_g, ln1_b, ln2_g, ln2_b, w_in_rec, conv_w, conv_b, w_gate_a, b_gate_a, w_gate_x, b_gate_x,
              lru_lambda, w_out_rec, w_qkv, w_o, w_router, b_router, w_gu, b_gu, w_down, b_down):
    for i in range(DEPTH):
        j = i // N_MIXERS
        if i % N_MIXERS == 0:
            y = _rg_lru_mixer(x, w_in_rec[j], conv_w[j], conv_b[j], w_gate_a[j], b_gate_a[j],
                              w_gate_x[j], b_gate_x[j], lru_lambda[j], w_out_rec[j])
        else:
            y = _moba_mixer(x, w_qkv[j], w_o[j])
        x = _layer_norm(DEEPNORM_ALPHA * x + y, ln1_g[i], ln1_b[i])
        y = _moe(x, w_router[i], b_router[i], w_gu[i], b_gu[i], w_down[i], b_down[i])
        x = _layer_norm(DEEPNORM_ALPHA * x + y, ln2_g[i], ln2_b[i])
    return x
```

```cpp
#include <hip/hip_runtime.h>
#include <cstdio>
#include <cstdint>

#define LAS __attribute__((address_space(3)))
#ifndef FP8_X
#define FP8_X 1
#endif
#ifndef FP8_IN
#define FP8_IN 1
#endif
#ifndef FP8_QKV
#define FP8_QKV FP8_X
#endif
#ifndef FP8_OUT
#define FP8_OUT 1
#endif
#define YMIX_SC 8.0f
#ifndef FP8_SCAN
#define FP8_SCAN 1
#endif
#define SCAN_SC 16.0f
#ifndef X1_RECOMPUTE
#define X1_RECOMPUTE (!Z_F32 && FP8_GU)
#endif
#ifndef Z_F32
#define Z_F32 0
#endif
#ifndef Y_F8
#define Y_F8 1
#endif
#ifndef FP8_GU
#define FP8_GU 1
#endif
#ifndef FP8_DN
#define FP8_DN 1
#endif
typedef unsigned short bf16_t;
typedef short bf16x8 __attribute__((ext_vector_type(8)));
typedef short s16x4 __attribute__((ext_vector_type(4)));
typedef float f32x2 __attribute__((ext_vector_type(2)));
typedef float f32x4 __attribute__((ext_vector_type(4)));
typedef float f32x16 __attribute__((ext_vector_type(16)));
typedef unsigned u32x2 __attribute__((ext_vector_type(2)));
typedef unsigned u32x4 __attribute__((ext_vector_type(4)));
typedef int v4i_t __attribute__((ext_vector_type(4)));
typedef int v8i_t __attribute__((ext_vector_type(8)));

constexpr int T = 32768, D = 1024, SEQ = 4096, NE = 32, DEPTH = 4;
constexpr float ALPHA = 1.681792830507429f;
constexpr float LN_EPS = 1e-5f;
constexpr int P_ROWS = 139264;

constexpr size_t MiB = 1u << 20;
constexpr size_t WS_CTL = 0, CTL_ZERO_BYTES = 64 * 1024;
constexpr size_t WS_KMH = 4 * MiB;
constexpr size_t WS_TOKG = 6 * MiB, WS_POS = 7 * MiB, WS_ROWTOK = 8 * MiB;
constexpr size_t WS_WIN = 16 * MiB;
constexpr size_t WS_WGATE = 24 * MiB;
constexpr size_t WS_WOUT = 32 * MiB;
constexpr size_t WS_WQKV = 40 * MiB;
constexpr size_t WS_WGU = 64 * MiB;
constexpr size_t WS_WDN = 576 * MiB;
constexpr size_t WS_XBF = 832 * MiB, WS_X1BF = 896 * MiB;
constexpr size_t WS_Z = 960 * MiB;
constexpr size_t WS_AGG = 1088 * MiB;
constexpr size_t WS_XF8 = 1140 * MiB;
constexpr size_t WS_X1F8 = 1100 * MiB;
constexpr size_t WS_YMIX = 1344 * MiB;
constexpr size_t WS_GG = 1408 * MiB, WS_REC = 1472 * MiB, WS_U = 1536 * MiB, WS_LA = 1600 * MiB, WS_BB = 1728 * MiB;
constexpr size_t WS_Q = 1408 * MiB, WS_K = 1472 * MiB, WS_V = 1536 * MiB;
static_assert(WS_K - WS_Q == 64 * MiB && WS_V - WS_K == 64 * MiB && WS_REC - WS_GG == 64 * MiB, "epilogue strides");
constexpr size_t WS_HBUF = 1856 * MiB, WS_YBUF = 2128 * MiB, WS_END = 2400 * MiB;

constexpr int LDS_SCRATCH = 135168;
constexpr int CV_SCR = 17024;
constexpr int MISC_OFF = 8 * CV_SCR;
constexpr int MISC_HIST = MISC_OFF + 64, MISC_TILE_E = MISC_OFF + 256, MISC_TAB = MISC_OFF + 1280;
constexpr int LDS_BYTES = MISC_OFF + 5120;
constexpr int RT_CAP = 32768;
constexpr int MISC_TF = MISC_OFF + 4352;
constexpr int MISC_BIAS = MISC_TAB + 1024;

#define LDS_WAIT() asm volatile("s_waitcnt lgkmcnt(0)" ::: "memory")
#define VM_WAIT() asm volatile("s_waitcnt vmcnt(0)" ::: "memory")

__device__ __forceinline__ unsigned f2bf(float f) { unsigned u = __float_as_uint(f); return (u + 0x7fffu + ((u >> 16) & 1u)) >> 16; }
__device__ __forceinline__ unsigned pk2(float lo, float hi) { return f2bf(lo) | (f2bf(hi) << 16); }
__device__ __forceinline__ float bflo(unsigned w) { return __uint_as_float(w << 16); }
__device__ __forceinline__ float bfhi(unsigned w) { return __uint_as_float(w & 0xffff0000u); }
__device__ __forceinline__ unsigned cvt_pk_bf16(float lo, float hi) { unsigned r; asm volatile("v_cvt_pk_bf16_f32 %0, %1, %2" : "=v"(r) : "v"(lo), "v"(hi)); return r; }
__device__ __forceinline__ unsigned pk4_fp8(float a, float b, float c, float d) { int w = 0; w = __builtin_amdgcn_cvt_pk_fp8_f32(a, b, w, false); w = __builtin_amdgcn_cvt_pk_fp8_f32(c, d, w, true); return (unsigned)w; }
__device__ __forceinline__ int opaque_tid() { int t = threadIdx.x; asm volatile("" : "+v"(t)); return t; }
template <int CTRL> __device__ __forceinline__ float dppf(float v) { return __uint_as_float(__builtin_amdgcn_update_dpp(0u, __float_as_uint(v), CTRL, 0xf, 0xf, true)); }
__device__ __forceinline__ float wave_sum_fast(float v) {
    v += dppf<0xB1>(v); v += dppf<0x4E>(v); v += dppf<0x141>(v); v += dppf<0x140>(v);
    { auto r = __builtin_amdgcn_permlane16_swap(__float_as_uint(v), __float_as_uint(v), false, false); v = __uint_as_float(r[0]) + __uint_as_float(r[1]); }
    { auto r = __builtin_amdgcn_permlane32_swap(__float_as_uint(v), __float_as_uint(v), false, false); v = __uint_as_float(r[0]) + __uint_as_float(r[1]); }
    return v;
}
__device__ __forceinline__ float wave_max_fast(float v) {
    v = fmaxf(v, dppf<0xB1>(v)); v = fmaxf(v, dppf<0x4E>(v)); v = fmaxf(v, dppf<0x141>(v)); v = fmaxf(v, dppf<0x140>(v));
    { auto r = __builtin_amdgcn_permlane16_swap(__float_as_uint(v), __float_as_uint(v), false, false); v = fmaxf(__uint_as_float(r[0]), __uint_as_float(r[1])); }
    { auto r = __builtin_amdgcn_permlane32_swap(__float_as_uint(v), __float_as_uint(v), false, false); v = fmaxf(__uint_as_float(r[0]), __uint_as_float(r[1])); }
    return v;
}
__device__ __forceinline__ float xr_pair(float a, float b) { auto r = __builtin_amdgcn_permlane32_swap(__float_as_uint(a), __float_as_uint(b), false, false); return __uint_as_float(r[0]) + __uint_as_float(r[1]); }
__device__ __forceinline__ float xreduce16(const float (&t16)[16], int lane) {
    float t8[8], t4[4], t2[2], lv;
#pragma unroll
    for (int j = 0; j < 8; ++j) { auto r = __builtin_amdgcn_permlane16_swap(__float_as_uint(t16[j]), __float_as_uint(t16[8 + j]), false, false); t8[j] = __uint_as_float(r[0]) + __uint_as_float(r[1]); }
    { const bool bt = (lane & 8) != 0;
#pragma unroll
      for (int j = 0; j < 4; ++j) { const float send = bt ? t8[j] : t8[4 + j]; t4[j] = (bt ? t8[4 + j] : t8[j]) + dppf<0x128>(send); } }
    { const bool bt = (lane & 4) != 0;
#pragma unroll
      for (int j = 0; j < 2; ++j) { const float send = bt ? t4[j] : t4[2 + j]; t2[j] = (bt ? t4[2 + j] : t4[j]) + dppf<0x1B>(dppf<0x141>(send)); } }
    { const bool bt = (lane & 2) != 0; const float send = bt ? t2[0] : t2[1]; lv = (bt ? t2[1] : t2[0]) + dppf<0x4E>(send); }
    lv += dppf<0xB1>(lv);
    return lv;
}
__device__ __forceinline__ float wave_sum(float v) {
#pragma unroll
    for (int o = 1; o < 64; o <<= 1) v += __shfl_xor(v, o);
    return v;
}

#define XB_TMO      128
#define XB_XCNT(j)  (256  + 64 * (j))
#define XB_XSUB(j)  (1280 + 64 * (j))
#define XB_XGEN(j)  (2304 + 64 * (j))
#define XB_TOP      3328
#define XB_TOPGEN   3392
#define XCD_BAR_WORDS 3456
#define XB_SPIN_CAP (1u << 21)

__device__ __forceinline__ unsigned xb_ld(unsigned* p)              { return __hip_atomic_load(p, __ATOMIC_RELAXED, __HIP_MEMORY_SCOPE_AGENT); }
__device__ __forceinline__ unsigned xb_add(unsigned* p, unsigned v) { return __hip_atomic_fetch_add(p, v, __ATOMIC_RELAXED, __HIP_MEMORY_SCOPE_AGENT); }
__device__ __forceinline__ unsigned xb_xcc_id() { return (unsigned)__builtin_amdgcn_s_getreg((3 << 11) | 20) & 0xFu; }
#define XB_SPIN(cond, bar) do { unsigned _sp = 0; while (cond) { __builtin_amdgcn_s_sleep(1); \
    if ((++_sp & 255u) == 0u) { if (xb_ld(&(bar)[XB_TMO])) break; if (_sp > XB_SPIN_CAP) { atomicAdd(&(bar)[XB_TMO], 1u); break; } } } } while (0)

struct XcdBarrier { unsigned* bar; unsigned x; volatile LAS unsigned* st; };

__device__ __forceinline__ XcdBarrier xcd_barrier_post(unsigned* bar, volatile LAS unsigned* st) {
    XcdBarrier b; b.bar = bar; b.x = xb_xcc_id(); b.st = st;
    if (threadIdx.x == 0) (void)xb_add(&bar[XB_XCNT(b.x)], 1u);
    return b;
}
__device__ __forceinline__ void xcd_barrier_complete(unsigned* bar, unsigned x, unsigned& nloc, unsigned& nx) {
    const unsigned G = gridDim.x * gridDim.y * gridDim.z;
    unsigned sum, cnt, mine, sp = 0u;
    for (;;) {
        sum = 0u; cnt = 0u; mine = 0u;
#pragma unroll
        for (unsigned j = 0; j < 16; ++j) { const unsigned c = xb_ld(&bar[XB_XCNT(j)]); sum += c; cnt += (c > 0u) ? 1u : 0u; mine = (j == x) ? c : mine; }
        if (sum == G) break;
        __builtin_amdgcn_s_sleep(1);
        if ((++sp & 255u) == 0u) { if (xb_ld(&bar[XB_TMO])) break; if (sp > XB_SPIN_CAP) { atomicAdd(&bar[XB_TMO], 1u); break; } }
    }
    nloc = mine > 0u ? mine : 1u; nx = cnt > 0u ? cnt : 1u;
}
__device__ __forceinline__ void xcd_barrier(const XcdBarrier& b) {
    asm volatile("s_waitcnt vmcnt(0)" ::: "memory");
    __syncthreads();
    if (threadIdx.x == 0) {
        unsigned* bar = b.bar;
        __builtin_amdgcn_s_waitcnt(0);
        unsigned nloc = b.st[0], nx = b.st[1];
        if (nloc == 0u) { xcd_barrier_complete(bar, b.x, nloc, nx); b.st[0] = nloc; b.st[1] = nx; }
        const unsigned old = xb_add(&bar[XB_XSUB(b.x)], 1u);
        const unsigned gen = old / nloc;
        if (old + 1u == (gen + 1u) * nloc) {
            __builtin_amdgcn_fence(__ATOMIC_RELEASE, "agent");
            asm volatile("s_waitcnt vmcnt(0)" ::: "memory");
            const unsigned og = xb_add(&bar[XB_TOP], 1u);
            const unsigned tg = og / nx;
            if (og + 1u == (tg + 1u) * nx) xb_add(&bar[XB_TOPGEN], 1u);
            else XB_SPIN(xb_ld(&bar[XB_TOPGEN]) == tg, bar);
            __builtin_amdgcn_fence(__ATOMIC_ACQUIRE, "agent");
            xb_add(&bar[XB_XGEN(b.x)], 1u);
            asm volatile("s_waitcnt vmcnt(0)" ::: "memory");
        } else {
            XB_SPIN(xb_ld(&bar[XB_XGEN(b.x)]) == gen, bar);
            __builtin_amdgcn_fence(__ATOMIC_ACQUIRE, "agent");
            asm volatile("s_waitcnt vmcnt(0)" ::: "memory");
        }
    }
    __syncthreads();
}

__device__ __forceinline__ const float* arg_ptr(int k);
namespace pg8 {
constexpr int BM = 256, BK = 64, HALF = 128, HTB = HALF * BK * 2, STAGE_BYTES = 8 * HTB, NXCD = 8, WGM = 8;
__host__ __device__ __forceinline__ int lds_byte(int r, int c) { const int st = (r >> 4) * 2 + (c >> 5), rr = r & 15, cc = c & 31, ob = rr * 64 + cc * 2; return st * 1024 + (ob ^ (((ob >> 9) & 1) << 5)); }
__host__ __device__ __forceinline__ void stage_rc(int b, int& R, int& C) { const int st = b / 1024, sb = b % 1024, swz = sb ^ (((sb >> 9) & 1) << 5); R = (st >> 1) * 16 + swz / 64; C = (st & 1) * 32 + (swz % 64) / 2; }
__host__ __device__ __forceinline__ int perm32(int rho) { const int n = rho >> 4, i = rho & 15; return 8 * (i >> 2) + 4 * n + (i & 3); }
struct Unit { int pm, pn; };
template <int NN> struct TileOrderT {
    int nM, nwg, G, c;
    static constexpr int nN = NN;
    __device__ void init(int nM_, int, int G_, int c_) { nM = nM_; nwg = nM * NN; G = G_; c = c_; }
    __device__ bool spare() const { const int rounds = (nwg + G - 1) / G, mine = (nwg - c + G - 1) / G; return mine < rounds; }
    __device__ bool next(int i, Unit& u) const {
        const int L = i * G + c; if (L >= nwg) return false;
        int wgid = L; { const int q = nwg >> 3, r = nwg & 7, xcd = wgid & 7, off = wgid >> 3; wgid = (xcd < r ? xcd * (q + 1) : r * (q + 1) + (xcd - r) * q) + off; }
        constexpr int nig = WGM * NN; const int gid = wgid / nig, fm = gid * WGM, w = wgid - gid * nig, gsz = (nM - fm) < WGM ? (nM - fm) : WGM;
        if (gsz == WGM) { u.pm = fm + (w & (WGM - 1)); u.pn = w >> 3; } else { u.pm = fm + (w % gsz); u.pn = w / gsz; }
        return true;
    }
};
template <bool F8_> struct SrcDenseT {
    static constexpr bool GATHER = false, FP8 = F8_; static constexpr int ES = F8_ ? 1 : 2;
    const char* A; const char* Bt; int lda; int K;
    __device__ __forceinline__ unsigned a_base(const Unit& u) const { return (unsigned)u.pm * 256u * lda * ES; }
    __device__ __forceinline__ void a_offs(const Unit&, const int (&)[2], const int (&)[2], unsigned (&)[2][2]) const {}
    __device__ __forceinline__ void idx_prefetch(const Unit&, int, int) const {}
    __device__ __forceinline__ void a_offs_lds(const int (&)[2], const int (&)[2], unsigned (&)[2][2]) const {}
    __device__ __forceinline__ unsigned b_base(const Unit& u) const { return (unsigned)u.pn * 256u * K * ES; }
};
typedef SrcDenseT<false> SrcDense;
struct SrcGates {
    static constexpr bool GATHER = false, FP8 = false;
    const char* A; const char* Bt; int lda;
    __device__ __forceinline__ unsigned a_base(const Unit& u) const { return ((unsigned)u.pm * 256u * lda + (unsigned)u.pn * 128u) * 2u; }
    __device__ __forceinline__ void a_offs(const Unit&, const int (&)[2], const int (&)[2], unsigned (&)[2][2]) const {}
    __device__ __forceinline__ void idx_prefetch(const Unit&, int, int) const {}
    __device__ __forceinline__ void a_offs_lds(const int (&)[2], const int (&)[2], unsigned (&)[2][2]) const {}
    __device__ __forceinline__ unsigned b_base(const Unit& u) const { return (unsigned)u.pn * 256u * 128u * 2u; }
};
template <bool F8_> struct SrcMoeGather {
    static constexpr bool GATHER = true, FP8 = F8_; static constexpr int ES = F8_ ? 1 : 2;
    const char* A; const char* Bt; const int* row_tok; const LAS unsigned char* tile_e; int lda; int nN; LAS int* idx; const LAS int* tfirst;
    __device__ __forceinline__ int rbase(const Unit& u) const { const int e = __builtin_amdgcn_readfirstlane((int)tile_e[u.pm]); return e * RT_CAP + (u.pm - __builtin_amdgcn_readfirstlane(tfirst[e])) * 256; }
    __device__ __forceinline__ unsigned a_base(const Unit&) const { return 0u; }
    __device__ __forceinline__ void a_offs(const Unit& u, const int (&RA)[2], const int (&CA)[2], unsigned (&ao)[2][2]) const {
        int tk[2][2];
#pragma unroll
        for (int h = 0; h < 2; ++h)
#pragma unroll
            for (int i = 0; i < 2; ++i) tk[h][i] = row_tok[rbase(u) + 128 * h + RA[i]];
#pragma unroll
        for (int h = 0; h < 2; ++h)
#pragma unroll
            for (int i = 0; i < 2; ++i) { ao[h][i] = (unsigned)(tk[h][i] * lda * ES + CA[i] * 2); asm volatile("" : "+v"(ao[h][i])); }
    }
    __device__ __forceinline__ void idx_prefetch(const Unit& u, int wid, int lane) const {
        if (wid < 4) __builtin_amdgcn_global_load_lds((const unsigned*)(row_tok + rbase(u) + wid * 64 + lane), (LAS unsigned*)(idx + wid * 64), 4, 0, 0);
    }
    __device__ __forceinline__ void a_offs_lds(const int (&RA)[2], const int (&CA)[2], unsigned (&ao)[2][2]) const {
#pragma unroll
        for (int h = 0; h < 2; ++h)
#pragma unroll
            for (int i = 0; i < 2; ++i) ao[h][i] = (unsigned)(idx[128 * h + RA[i]] * lda * ES + CA[i] * 2);
    }
    __device__ __forceinline__ unsigned b_base(const Unit& u) const { const int e = __builtin_amdgcn_readfirstlane((int)tile_e[u.pm]); return ((unsigned)e * nN + u.pn) * 256u * lda * ES; }
};
template <bool F8_> struct SrcMoeDense {
    static constexpr bool GATHER = false, FP8 = F8_; static constexpr int ES = F8_ ? 1 : 2;
    const char* A; const char* Bt; const LAS unsigned char* tile_e; int lda; int nN;
    __device__ __forceinline__ unsigned a_base(const Unit& u) const { return (unsigned)u.pm * 256u * lda * ES; }
    __device__ __forceinline__ void a_offs(const Unit&, const int (&)[2], const int (&)[2], unsigned (&)[2][2]) const {}
    __device__ __forceinline__ void idx_prefetch(const Unit&, int, int) const {}
    __device__ __forceinline__ void a_offs_lds(const int (&)[2], const int (&)[2], unsigned (&)[2][2]) const {}
    __device__ __forceinline__ unsigned b_base(const Unit& u) const { const int e = __builtin_amdgcn_readfirstlane((int)tile_e[u.pm]); return ((unsigned)e * nN + u.pn) * 256u * lda * ES; }
};

template <class Epi, class Src, class Ord>
__device__ __forceinline__ void gemm_phase(LAS unsigned char* lds, const int K, const Ord& S, const Src& X, const Epi& E) {
    const int tid = opaque_tid(), wid = __builtin_amdgcn_readfirstlane(tid >> 6), lane = tid & 63, wr = wid >> 2, wc = wid & 3, fr = lane & 15, fq = lane >> 4;
    constexpr bool F8 = Src::FP8; constexpr int ES = F8 ? 1 : 2;
    const int nt = K * ES / (BK * 2);
    constexpr bool GA = Src::GATHER;
    int RA[2], CA[2]; unsigned voffA[2], voffB[2];
#pragma unroll
    for (int i = 0; i < 2; ++i) { int R, C; stage_rc(tid * 16 + i * 8192, R, C); RA[i] = R; CA[i] = C; const int Rb = Epi::PERM ? ((R & ~31) + perm32(R & 31)) : R;
        voffA[i] = (unsigned)(R * X.lda * ES + C * 2); voffB[i] = (unsigned)(Rb * K * ES + C * 2); }
    const unsigned kstep = (unsigned)(BK * 2);
    const unsigned hstep = (unsigned)HALF * K * ES;
    const unsigned hstepA = GA ? 0u : (unsigned)HALF * X.lda * ES;
    const __amdgpu_buffer_rsrc_t rsA = __builtin_amdgcn_make_buffer_rsrc((void*)X.A, 0, 0x7fffffff, 0x00020000), rsB = __builtin_amdgcn_make_buffer_rsrc((void*)X.Bt, 0, 0x7fffffff, 0x00020000);
    const unsigned ldsw = (unsigned)wid * 1024u;
    const int aoff = lds_byte(wr * 64 + fr, fq * 8), boff = lds_byte(wc * 32 + fr, fq * 8);
#define PG8_SA(b, h) (((b) * 2 + (h)) * HTB)
#define PG8_SB(b, h) ((4 + (b) * 2 + (h)) * HTB)
#define PG8_STAGE_R(rs, bufoff, soff, voff) do { _Pragma("unroll") for (int _i = 0; _i < 2; ++_i) \
        __builtin_amdgcn_raw_ptr_buffer_load_lds(rs, (LAS void*)(lds + (bufoff) + ldsw + _i * 8192), 16, (int)(voff)[_i], (int)(soff), 0, 0); } while (0)
#define PG8_STAGE(bufoff, soff, voff) PG8_STAGE_R(rsB, bufoff, soff, voff)
#define PG8_STAGE_A(bufoff, soff, h, g0, g1) do { if constexpr (GA) { unsigned _o[2] = {g0, g1}; PG8_STAGE_R(rsA, bufoff, soff, _o); } else { PG8_STAGE_R(rsA, bufoff, (soff) + ((h) ? hstepA : 0u), voffA); } } while (0)
#define PG8_LDA(dst, b, h) do { _Pragma("unroll") for (int m = 0; m < 4; ++m) _Pragma("unroll") for (int k = 0; k < 2; ++k) dst[m][k] = *(const LAS bf16x8*)(lds + PG8_SA(b, h) + aoff + m * 2048 + k * 1024); } while (0)
#define PG8_LDB(dst, b, h) do { _Pragma("unroll") for (int n = 0; n < 2; ++n) _Pragma("unroll") for (int k = 0; k < 2; ++k) dst[n][k] = *(const LAS bf16x8*)(lds + PG8_SB(b, h) + boff + n * 2048 + k * 1024); } while (0)
#define PG8_CAT(x0, x1) __builtin_shufflevector(__builtin_bit_cast(v4i_t, x0), __builtin_bit_cast(v4i_t, x1), 0, 1, 2, 3, 4, 5, 6, 7)
#define PG8_MMA(ai, bj, At, Bt) do { __builtin_amdgcn_s_setprio(1); \
        if constexpr (F8) { _Pragma("unroll") for (int n = 0; n < 2; ++n) { const v8i_t b8_ = PG8_CAT(Bt[n][0], Bt[n][1]); _Pragma("unroll") for (int m = 0; m < 4; ++m) { const v8i_t a8_ = PG8_CAT(At[m][0], At[m][1]); \
            asm volatile("v_mfma_f32_16x16x128_f8f6f4 %0, %1, %2, %0" : "+v"(acc[ai][bj][m][n]) : "v"(b8_), "v"(a8_)); } } }     \
        else { _Pragma("unroll") for (int m = 0; m < 4; ++m) _Pragma("unroll") for (int n = 0; n < 2; ++n) _Pragma("unroll") for (int k = 0; k < 2; ++k) \
            acc[ai][bj][m][n] = __builtin_amdgcn_mfma_f32_16x16x32_bf16(Bt[n][k], At[m][k], acc[ai][bj][m][n], 0, 0, 0); } \
        __builtin_amdgcn_s_setprio(0); } while (0)
#define PG8_MMA_Z(ai, bj, At, Bt) do { if constexpr (F8 && Epi::ZC) { if (t == 0) { __builtin_amdgcn_s_setprio(1); \
            _Pragma("unroll") for (int n = 0; n < 2; ++n) { const v8i_t b8_ = PG8_CAT(Bt[n][0], Bt[n][1]); _Pragma("unroll") for (int m = 0; m < 4; ++m) { const v8i_t a8_ = PG8_CAT(At[m][0], At[m][1]); \
                asm volatile("v_mfma_f32_16x16x128_f8f6f4 %0, %1, %2, 0" : "+v"(acc[ai][bj][m][n]) : "v"(b8_), "v"(a8_)); } }     \
            __builtin_amdgcn_s_setprio(0); } else PG8_MMA(ai, bj, At, Bt); } else PG8_MMA(ai, bj, At, Bt); } while (0)
#define PG8_WAIT_V(n) asm volatile("s_waitcnt vmcnt(" #n ")" ::: "memory")
#define PG8_WAIT_L(n) asm volatile("s_waitcnt lgkmcnt(" #n ")" ::: "memory")
#define PG8_BAR __builtin_amdgcn_s_barrier()
#define PG8_SCHED __builtin_amdgcn_sched_barrier(0)
    Unit cur, nxt; int ui = 0;
    if (!S.next(0, cur)) return;
    f32x4 acc[2][2][4][2];
    if constexpr (!(F8 && Epi::ZC)) {
#pragma unroll
    for (int a = 0; a < 2; ++a)
#pragma unroll
        for (int b = 0; b < 2; ++b)
#pragma unroll
            for (int m = 0; m < 4; ++m)
#pragma unroll
                for (int n = 0; n < 2; ++n) acc[a][b][m][n] = (f32x4){0.f, 0.f, 0.f, 0.f}; }
    bf16x8 At[4][2], B0[2][2], B1[2][2];
    unsigned ao[2][2] = {{0u, 0u}, {0u, 0u}}, nao[2][2] = {{0u, 0u}, {0u, 0u}};
    unsigned cA = X.a_base(cur); if constexpr (GA) X.a_offs(cur, RA, CA, ao);
    unsigned cB = X.b_base(cur);
    PG8_STAGE(PG8_SB(0, 0), cB, voffB); PG8_STAGE_A(PG8_SA(0, 0), cA, 0, ao[0][0], ao[0][1]); PG8_STAGE(PG8_SB(0, 1), cB + hstep, voffB); PG8_STAGE_A(PG8_SA(0, 1), cA, 1, ao[1][0], ao[1][1]);
    if (wr == 1) PG8_BAR;
    PG8_WAIT_V(4); PG8_BAR;
    PG8_STAGE(PG8_SB(1, 0), cB + kstep, voffB); PG8_STAGE_A(PG8_SA(1, 0), cA + kstep, 0, ao[0][0], ao[0][1]); PG8_STAGE(PG8_SB(1, 1), cB + hstep + kstep, voffB);
    PG8_WAIT_V(6); PG8_BAR;
    for (;;) {
        const bool has_next = S.next(ui + 1, nxt);
        E.prefetch(cur, ui, wid, lane);
        unsigned nA = cA, nB = cB;
        if constexpr (GA) {
#pragma unroll
            for (int h = 0; h < 2; ++h)
#pragma unroll
                for (int i = 0; i < 2; ++i) nao[h][i] = ao[h][i]; }
        if (has_next) { nA = X.a_base(nxt); nB = X.b_base(nxt); if constexpr (GA) X.idx_prefetch(nxt, wid, lane); }
        for (int t = 0; t < nt; t += 2) {
            const bool last = (t == nt - 2);
            if constexpr (GA) { if (last && has_next) X.a_offs_lds(RA, CA, nao); }
            const unsigned a1 = cA + (unsigned)(t + 1) * kstep;
            const unsigned a2 = last ? nA : cA + (unsigned)(t + 2) * kstep, b2 = last ? nB : cB + (unsigned)(t + 2) * kstep;
            const unsigned a3 = a2 + kstep, b3 = b2 + kstep;
            unsigned s00 = 0u, s01 = 0u, s10 = 0u, s11 = 0u;
            if constexpr (GA) { s00 = last ? nao[0][0] : ao[0][0]; s01 = last ? nao[0][1] : ao[0][1]; s10 = last ? nao[1][0] : ao[1][0]; s11 = last ? nao[1][1] : ao[1][1]; }
            PG8_LDB(B0, 0, 0); PG8_SCHED; PG8_LDA(At, 0, 0); PG8_STAGE_A(PG8_SA(1, 1), a1, 1, ao[1][0], ao[1][1]);
            PG8_WAIT_L(8); PG8_BAR; PG8_WAIT_L(0); PG8_MMA_Z(0, 0, At, B0); PG8_BAR; PG8_SCHED;
            PG8_LDB(B1, 0, 1); PG8_STAGE(PG8_SB(0, 0), b2, voffB);
            PG8_BAR; PG8_WAIT_L(0); PG8_MMA_Z(0, 1, At, B1); PG8_BAR;
            PG8_LDA(At, 0, 1); PG8_STAGE_A(PG8_SA(0, 0), a2, 0, s00, s01);
            PG8_BAR; PG8_WAIT_L(0); PG8_MMA_Z(1, 0, At, B0); PG8_BAR; PG8_SCHED;
            PG8_STAGE(PG8_SB(0, 1), b2 + hstep, voffB);
            PG8_WAIT_V(6); PG8_BAR; PG8_MMA_Z(1, 1, At, B1); PG8_BAR;
            PG8_LDB(B0, 1, 0); PG8_SCHED; PG8_LDA(At, 1, 0); PG8_STAGE_A(PG8_SA(0, 1), a2, 1, s10, s11);
            PG8_WAIT_L(8); PG8_BAR; PG8_WAIT_L(0); PG8_MMA(0, 0, At, B0); PG8_BAR; PG8_SCHED;
            PG8_LDB(B1, 1, 1); PG8_STAGE(PG8_SB(1, 0), b3, voffB);
            PG8_BAR; PG8_WAIT_L(0); PG8_MMA(0, 1, At, B1); PG8_BAR;
            PG8_LDA(At, 1, 1); PG8_STAGE_A(PG8_SA(1, 0), a3, 0, s00, s01);
            PG8_BAR; PG8_WAIT_L(0); PG8_MMA(1, 0, At, B0); PG8_BAR; PG8_SCHED;
            PG8_STAGE(PG8_SB(1, 1), b3 + hstep, voffB);
            PG8_WAIT_V(6); PG8_BAR; PG8_MMA(1, 1, At, B1); PG8_BAR;
        }
        { const int tz = opaque_tid(); const int wz = __builtin_amdgcn_readfirstlane(tz >> 6), lz = tz & 63;
          E(acc, cur, wz >> 2, wz & 3, lz & 15, lz >> 4, ui); }
        if (!has_next) break;
        if constexpr (!(F8 && Epi::ZC))
#pragma unroll
        for (int a = 0; a < 2; ++a)
#pragma unroll
            for (int b = 0; b < 2; ++b)
#pragma unroll
                for (int m = 0; m < 4; ++m)
#pragma unroll
                    for (int n = 0; n < 2; ++n) acc[a][b][m][n] = (f32x4){0.f, 0.f, 0.f, 0.f};
        cur = nxt; cA = nA; cB = nB; ++ui;
        if constexpr (GA) {
#pragma unroll
            for (int h = 0; h < 2; ++h)
#pragma unroll
                for (int i = 0; i < 2; ++i) ao[h][i] = nao[h][i]; }
    }
    PG8_WAIT_V(0);
    if (wr == 0) PG8_BAR;
    PG8_BAR;
#undef PG8_SA
#undef PG8_SB
#undef PG8_STAGE
#undef PG8_STAGE_R
#undef PG8_STAGE_A
#undef PG8_LDA
#undef PG8_LDB
#undef PG8_MMA
#undef PG8_CAT
#undef PG8_WAIT_V
#undef PG8_WAIT_L
#undef PG8_BAR
#undef PG8_SCHED
}

__device__ __forceinline__ float sigmoidf_(float x) { return __builtin_amdgcn_rcpf(1.0f + __expf(-x)); }
__device__ __forceinline__ f32x4 gelu_tanh4(f32x4 x) {
    f32x4 t = x * (x * x * 0.044715f + 1.0f) * (-2.0f * 0.7978845608028654f * 1.4426950408889634f);
    t[0] = __builtin_amdgcn_exp2f(t[0]); t[1] = __builtin_amdgcn_exp2f(t[1]); t[2] = __builtin_amdgcn_exp2f(t[2]); t[3] = __builtin_amdgcn_exp2f(t[3]);
    t = t + 1.0f;
    t[0] = __builtin_amdgcn_rcpf(t[0]); t[1] = __builtin_amdgcn_rcpf(t[1]); t[2] = __builtin_amdgcn_rcpf(t[2]); t[3] = __builtin_amdgcn_rcpf(t[3]);
    return x * t;
}
__device__ __forceinline__ float gelu_tanh(float x) { const float t = 0.7978845608028654f * (x + 0.044715f * x * x * x); return x * __builtin_amdgcn_rcpf(1.0f + __expf(-2.0f * t)); }

struct EpiIn {
    static constexpr bool PERM = true, ZC = true;
    bf16_t* gg; float asc;
    __device__ __forceinline__ void prefetch(const Unit&, int, int, int) const {}
    __device__ __forceinline__ void operator()(const f32x4 (&acc)[2][2][4][2], const Unit& u, int wr, int wc, int fr, int fq, int) const {
        const bool is_gate = u.pn < 4;
        bf16_t* base = gg + (is_gate ? (size_t)0 : (size_t)(32u << 20));
        const int row0 = u.pm * BM + wr * 64 + fr, col0 = (u.pn & 3) * BM + wc * 32 + 8 * fq;
#pragma unroll
        for (int ai = 0; ai < 2; ++ai)
#pragma unroll
            for (int m = 0; m < 4; ++m) { bf16_t* rowp = base + (size_t)(row0 + ai * HALF + m * 16) * D + col0;
#pragma unroll
                for (int bj = 0; bj < 2; ++bj) { f32x4 v0 = acc[ai][bj][m][0] * asc, v1 = acc[ai][bj][m][1] * asc;
                    if (is_gate) { v0 = gelu_tanh4(v0); v1 = gelu_tanh4(v1); }
                    if (FP8_SCAN && is_gate) { v0 = v0 * SCAN_SC; v1 = v1 * SCAN_SC; u32x2 w; w.x = pk4_fp8(v0[0], v0[1], v0[2], v0[3]); w.y = pk4_fp8(v1[0], v1[1], v1[2], v1[3]);
                        *(u32x2*)((unsigned char*)gg + (size_t)(row0 + ai * HALF + m * 16) * D + col0 + bj * HALF) = w; }
                    else { u32x4 w; w.x = cvt_pk_bf16(v0[0], v0[1]); w.y = cvt_pk_bf16(v0[2], v0[3]); w.z = cvt_pk_bf16(v1[0], v1[1]); w.w = cvt_pk_bf16(v1[2], v1[3]);
                    *(u32x4*)(rowp + bj * HALF) = w; } } }
    }
};
struct EpiQKV {
    static constexpr bool PERM = true, ZC = false;
    static constexpr float asc = FP8_QKV ? (1.0f / 32.0f) : 1.0f;
    __device__ __forceinline__ void prefetch(const Unit&, int, int, int) const {}
    __device__ __forceinline__ void operator()(const f32x4 (&acc)[2][2][4][2], const Unit& u, int wr, int wc, int fr, int fq, int) const {
        const int which = u.pn >> 2;
        unsigned char* wsb = (unsigned char*)arg_ptr(23);
        bf16_t* base = (bf16_t*)(wsb + WS_Q) + (size_t)which * (size_t)(32u << 20);
        float* ksum = (float*)(wsb + WS_KMH);
        const int row0 = u.pm * BM + wr * 64 + fr, col0 = (u.pn & 3) * BM + wc * 32 + 8 * fq;
        f32x4 ks[2][2] = {};
        float crev[4];
#pragma unroll
        for (int j = 0; j < 4; ++j) crev[j] = __builtin_amdgcn_exp2f(-(float)(16 * wc + 4 * fq + j) * (13.287712379549449f / 64.0f)) * 0.15915494309189535f;
#pragma unroll
        for (int ai = 0; ai < 2; ++ai)
#pragma unroll
            for (int m = 0; m < 4; ++m) { const int row = row0 + ai * HALF + m * 16; bf16_t* rowp = base + (size_t)row * D + col0;
                float c0 = 1.f, c1 = 1.f, c2 = 1.f, c3 = 1.f, s0 = 0.f, s1 = 0.f, s2 = 0.f, s3 = 0.f;
                if (which < 2) { const float sp = (float)(row & (SEQ - 1));
                    const float x0 = __builtin_amdgcn_fractf(sp * crev[0]), x1 = __builtin_amdgcn_fractf(sp * crev[1]), x2 = __builtin_amdgcn_fractf(sp * crev[2]), x3 = __builtin_amdgcn_fractf(sp * crev[3]);
                    c0 = __builtin_amdgcn_cosf(x0); c1 = __builtin_amdgcn_cosf(x1); c2 = __builtin_amdgcn_cosf(x2); c3 = __builtin_amdgcn_cosf(x3);
                    s0 = __builtin_amdgcn_sinf(x0); s1 = __builtin_amdgcn_sinf(x1); s2 = __builtin_amdgcn_sinf(x2); s3 = __builtin_amdgcn_sinf(x3); }
                const f32x4 cs = (f32x4){c0, c1, c2, c3}, sn = (f32x4){s0, s1, s2, s3};
#pragma unroll
                for (int bj = 0; bj < 2; ++bj) { const f32x4 t1 = acc[ai][bj][m][0] * asc, t2 = acc[ai][bj][m][1] * asc;
                    const f32x4 o1 = t1 * cs - t2 * sn, o2 = t2 * cs + t1 * sn;
                    ks[bj][0] += o1; ks[bj][1] += o2;
                    u32x4 w; w.x = cvt_pk_bf16(o1[0], o1[1]); w.y = cvt_pk_bf16(o1[2], o1[3]); w.z = cvt_pk_bf16(o2[0], o2[1]); w.w = cvt_pk_bf16(o2[2], o2[3]);
                    *(u32x4*)(rowp + bj * HALF) = w; } }
        if (which == 1) {
            float* kp = ksum + (size_t)u.pm * D + col0;
#pragma unroll
            for (int bj = 0; bj < 2; ++bj)
#pragma unroll
                for (int h2 = 0; h2 < 2; ++h2)
#pragma unroll
                    for (int e = 0; e < 4; ++e) { float v = ks[bj][h2][e];
                        v += dppf<0xB1>(v); v += dppf<0x4E>(v); v += dppf<0x141>(v); v += dppf<0x140>(v);
                        if (fr == 0) __hip_atomic_fetch_add(kp + bj * HALF + 4 * h2 + e, v, __ATOMIC_RELAXED, __HIP_MEMORY_SCOPE_AGENT); } }
    }
};
struct EpiOut {
    static constexpr bool PERM = true, ZC = true;
    void* z; const bf16_t* xres; float asc;
    __device__ __forceinline__ void prefetch(const Unit&, int, int, int) const {}
    __device__ __forceinline__ void operator()(const f32x4 (&acc)[2][2][4][2], const Unit& u, int wr, int wc, int fr, int fq, int) const {
        const int row0 = u.pm * BM + wr * 64 + fr, col0 = u.pn * BM + wc * 32 + 8 * fq;
        u32x4 xw[2][4][2];
#pragma unroll
        for (int ai = 0; ai < 2; ++ai)
#pragma unroll
            for (int m = 0; m < 4; ++m)
#pragma unroll
                for (int bj = 0; bj < 2; ++bj) xw[ai][m][bj] = *(const u32x4*)(xres + (size_t)(row0 + ai * HALF + m * 16) * D + col0 + bj * HALF);
#pragma unroll
        for (int ai = 0; ai < 2; ++ai)
#pragma unroll
            for (int m = 0; m < 4; ++m) { const size_t off = (size_t)(row0 + ai * HALF + m * 16) * D + col0;
#pragma unroll
                for (int bj = 0; bj < 2; ++bj) { const u32x4 w4 = xw[ai][m][bj];
                    const f32x4 x0 = (f32x4){bflo(w4.x), bfhi(w4.x), bflo(w4.y), bfhi(w4.y)}, x1 = (f32x4){bflo(w4.z), bfhi(w4.z), bflo(w4.w), bfhi(w4.w)};
                    const f32x4 v0 = FP8_OUT ? acc[ai][bj][m][0] * asc + x0 * ALPHA : acc[ai][bj][m][0] + x0 * ALPHA, v1 = FP8_OUT ? acc[ai][bj][m][1] * asc + x1 * ALPHA : acc[ai][bj][m][1] + x1 * ALPHA;
                    if (Z_F32) { *(f32x4*)((float*)z + off + bj * HALF) = v0; *(f32x4*)((float*)z + off + bj * HALF + 4) = v1; }
                    else { u32x4 w; w.x = cvt_pk_bf16(v0[0], v0[1]); w.y = cvt_pk_bf16(v0[2], v0[3]); w.z = cvt_pk_bf16(v1[0], v1[1]); w.w = cvt_pk_bf16(v1[2], v1[3]);
                    *(u32x4*)((bf16_t*)z + off + bj * HALF) = w; } } }
    }
};
struct EpiGates {
    static constexpr bool PERM = true, ZC = true;
    bf16_t* la; bf16_t* bb; const bf16_t* ub; const float* bga; const float* bgx; const float* lam;
    __device__ __forceinline__ void prefetch(const Unit&, int, int, int) const {}
    __device__ __forceinline__ void operator()(const f32x4 (&acc)[2][2][4][2], const Unit& u, int wr, int wc, int fr, int fq, int) const {
        const int row0 = u.pm * BM + wr * 64 + fr, ch0 = u.pn * HALF + wc * 32 + 8 * fq;
        f32x4 ba[2], bx[2], ls[2];
#pragma unroll
        for (int n = 0; n < 2; ++n) { ba[n] = *(const f32x4*)(bga + ch0 + n * 4); bx[n] = *(const f32x4*)(bgx + ch0 + n * 4); const f32x4 l = *(const f32x4*)(lam + ch0 + n * 4);
#pragma unroll
            for (int j = 0; j < 4; ++j) ls[n][j] = -8.0f * log1pf(__expf(-l[j])); }
        u32x4 uws[2][4];
#pragma unroll
        for (int ai = 0; ai < 2; ++ai)
#pragma unroll
            for (int m = 0; m < 4; ++m) uws[ai][m] = *(const u32x4*)(ub + (size_t)(row0 + ai * HALF + m * 16) * D + ch0);
#pragma unroll
        for (int ai = 0; ai < 2; ++ai)
#pragma unroll
            for (int m = 0; m < 4; ++m) { const int row = row0 + ai * HALF + m * 16; const size_t off = (size_t)row * D + ch0; const bool first = (row & (SEQ - 1)) == 0;
                const u32x4 uw = uws[ai][m];
                const float uv[2][4] = {{bflo(uw.x), bfhi(uw.x), bflo(uw.y), bfhi(uw.y)}, {bflo(uw.z), bfhi(uw.z), bflo(uw.w), bfhi(uw.w)}};
                f32x4 lo[2], bo[2];
#pragma unroll
                for (int n = 0; n < 2; ++n)
#pragma unroll
                    for (int j = 0; j < 4; j += 2) {
                        f32x2 ea = ((f32x2){acc[ai][0][m][n][j], acc[ai][0][m][n][j + 1]} + (f32x2){ba[n][j], ba[n][j + 1]}) * -1.4426950408889634f;
                        f32x2 ex = ((f32x2){acc[ai][1][m][n][j], acc[ai][1][m][n][j + 1]} + (f32x2){bx[n][j], bx[n][j + 1]}) * -1.4426950408889634f;
                        ea[0] = __builtin_amdgcn_exp2f(ea[0]); ea[1] = __builtin_amdgcn_exp2f(ea[1]); ex[0] = __builtin_amdgcn_exp2f(ex[0]); ex[1] = __builtin_amdgcn_exp2f(ex[1]);
                        ea = ea + 1.0f; ex = ex + 1.0f;
                        f32x2 sa, sx; sa[0] = __builtin_amdgcn_rcpf(ea[0]); sa[1] = __builtin_amdgcn_rcpf(ea[1]); sx[0] = __builtin_amdgcn_rcpf(ex[0]); sx[1] = __builtin_amdgcn_rcpf(ex[1]);
                        const f32x2 l2 = sa * (f32x2){ls[n][j], ls[n][j + 1]}; const f32x2 t2 = l2 * -2.0f;
                        const f32x2 ser = t2 * (t2 * -0.5f + 1.0f); f32x2 dx = t2 * -1.4426950408889634f; dx[0] = __builtin_amdgcn_exp2f(dx[0]); dx[1] = __builtin_amdgcn_exp2f(dx[1]); dx = 1.0f - dx;
                        f32x2 mult; mult[0] = first ? 1.0f : __builtin_amdgcn_sqrtf(t2[0] < 1e-3f ? ser[0] : dx[0]); mult[1] = first ? 1.0f : __builtin_amdgcn_sqrtf(t2[1] < 1e-3f ? ser[1] : dx[1]);
                        const f32x2 b2 = mult * sx * (f32x2){uv[n][j], uv[n][j + 1]};
                        lo[n][j] = l2[0]; lo[n][j + 1] = l2[1]; bo[n][j] = b2[0]; bo[n][j + 1] = b2[1]; }
                u32x4 w; w.x = cvt_pk_bf16(lo[0][0], lo[0][1]); w.y = cvt_pk_bf16(lo[0][2], lo[0][3]); w.z = cvt_pk_bf16(lo[1][0], lo[1][1]); w.w = cvt_pk_bf16(lo[1][2], lo[1][3]);
                *(u32x4*)(la + off) = w;
                if (FP8_SCAN) { const f32x4 s0 = bo[0] * SCAN_SC, s1 = bo[1] * SCAN_SC; u32x2 w8; w8.x = pk4_fp8(s0[0], s0[1], s0[2], s0[3]); w8.y = pk4_fp8(s1[0], s1[1], s1[2], s1[3]); *(u32x2*)((unsigned char*)bb + off) = w8; }
                else { w.x = cvt_pk_bf16(bo[0][0], bo[0][1]); w.y = cvt_pk_bf16(bo[0][2], bo[0][3]); w.z = cvt_pk_bf16(bo[1][0], bo[1][1]); w.w = cvt_pk_bf16(bo[1][2], bo[1][3]);
                *(u32x4*)(bb + off) = w; } }
    }
};
template <bool IN8, bool OUT8> struct EpiGU {
    static constexpr bool PERM = true, ZC = true;
    void* hb; const float* bgu; const LAS unsigned char* tile_e; LAS float* bl;
    __device__ __forceinline__ void prefetch(const Unit& u, int ui, int wid, int lane) const {
        if (wid < 4) { const int e = __builtin_amdgcn_readfirstlane((int)tile_e[u.pm]);
            const float* src = bgu + (size_t)e * 2048 + (wid >> 1) * 1024 + u.pn * HALF + (wid & 1) * 64 + lane;
            __builtin_amdgcn_global_load_lds((const unsigned*)src, (LAS unsigned*)(bl + (ui & 1) * 256 + wid * 64), 4, 0, 0); }
    }
    __device__ __forceinline__ void operator()(const f32x4 (&acc)[2][2][4][2], const Unit& u, int wr, int wc, int fr, int fq, int ui) const {
        const int row0 = u.pm * BM + wr * 64 + fr, col0 = u.pn * HALF + wc * 32 + 8 * fq;
        const LAS float* bp = bl + (ui & 1) * 256 + wc * 32 + 8 * fq;
        const f32x4 bg0 = *(const LAS f32x4*)(bp), bg1 = *(const LAS f32x4*)(bp + 4), bu0 = *(const LAS f32x4*)(bp + 128) + 1.0f, bu1 = *(const LAS f32x4*)(bp + 132) + 1.0f;
#pragma unroll
        for (int ai = 0; ai < 2; ++ai)
#pragma unroll
            for (int m = 0; m < 4; ++m) { const size_t eoff = (size_t)(row0 + ai * HALF + m * 16) * D + col0; constexpr float asc = IN8 ? (1.0f / 32.0f) : 1.0f;
                f32x4 h0, h1;
#define GU_PAIR(HO, N_, BG, BU, J0) do { f32x2 g2 = __builtin_elementwise_fma((f32x2){acc[ai][0][m][N_][J0], acc[ai][0][m][N_][J0 + 1]}, (f32x2){asc, asc}, (f32x2){BG[J0], BG[J0 + 1]});     \
                    f32x2 u2 = __builtin_elementwise_fma((f32x2){acc[ai][1][m][N_][J0], acc[ai][1][m][N_][J0 + 1]}, (f32x2){asc, asc}, (f32x2){BU[J0], BU[J0 + 1]});                                                     \
                    g2[0] = fminf(g2[0], 7.0f); g2[1] = fminf(g2[1], 7.0f); u2[0] = __builtin_amdgcn_fmed3f(u2[0], -6.0f, 8.0f); u2[1] = __builtin_amdgcn_fmed3f(u2[1], -6.0f, 8.0f);     \
                    f32x2 e2 = g2 * -2.45546696f; e2[0] = __builtin_amdgcn_exp2f(e2[0]); e2[1] = __builtin_amdgcn_exp2f(e2[1]); e2 = e2 + 1.0f;                             \
                    f32x2 r2; r2[0] = __builtin_amdgcn_rcpf(e2[0]); r2[1] = __builtin_amdgcn_rcpf(e2[1]);                                                                     \
                    const f32x2 hh = u2 * (g2 * r2); HO[J0] = hh[0]; HO[J0 + 1] = hh[1]; } while (0)
                GU_PAIR(h0, 0, bg0, bu0, 0); GU_PAIR(h0, 0, bg0, bu0, 2); GU_PAIR(h1, 1, bg1, bu1, 0); GU_PAIR(h1, 1, bg1, bu1, 2);
#undef GU_PAIR
                if constexpr (OUT8) { u32x2 w; w.x = pk4_fp8(h0[0], h0[1], h0[2], h0[3]); w.y = pk4_fp8(h1[0], h1[1], h1[2], h1[3]); *(u32x2*)((unsigned char*)hb + eoff) = w; }
                else { u32x4 w; w.x = cvt_pk_bf16(h0[0], h0[1]); w.y = cvt_pk_bf16(h0[2], h0[3]); w.z = cvt_pk_bf16(h1[0], h1[1]); w.w = cvt_pk_bf16(h1[2], h1[3]); *(u32x4*)((bf16_t*)hb + eoff) = w; } }
    }
};
template <bool IN8> struct EpiDown {
    static constexpr bool PERM = true, ZC = true;
    void* yb; const float* bdn; const LAS unsigned char* tile_e; LAS float* bl;
    __device__ __forceinline__ void prefetch(const Unit& u, int ui, int wid, int lane) const {
        if (wid < 4) { const int e = __builtin_amdgcn_readfirstlane((int)tile_e[u.pm]);
            __builtin_amdgcn_global_load_lds((const unsigned*)(bdn + (size_t)e * D + u.pn * BM + wid * 64 + lane), (LAS unsigned*)(bl + (ui & 1) * 256 + wid * 64), 4, 0, 0); }
    }
    __device__ __forceinline__ void operator()(const f32x4 (&acc)[2][2][4][2], const Unit& u, int wr, int wc, int fr, int fq, int ui) const {
        const int row0 = u.pm * BM + wr * 64 + fr, col0 = u.pn * BM + wc * 32 + 8 * fq;
        f32x4 bv[2][2];
#pragma unroll
        for (int bj = 0; bj < 2; ++bj)
#pragma unroll
            for (int n = 0; n < 2; ++n) bv[bj][n] = *(const LAS f32x4*)(bl + (ui & 1) * 256 + bj * HALF + wc * 32 + 8 * fq + 4 * n) * (Y_F8 ? 16.0f : 1.0f);
#pragma unroll
        for (int ai = 0; ai < 2; ++ai)
#pragma unroll
            for (int m = 0; m < 4; ++m) { const size_t eoff = (size_t)(row0 + ai * HALF + m * 16) * D + col0;
#pragma unroll
                for (int bj = 0; bj < 2; ++bj) { constexpr float asc = (IN8 ? (1.0f / 64.0f) : 1.0f) * (Y_F8 ? 16.0f : 1.0f); const f32x4 v0 = __builtin_elementwise_fma(acc[ai][bj][m][0], (f32x4){asc, asc, asc, asc}, bv[bj][0]), v1 = __builtin_elementwise_fma(acc[ai][bj][m][1], (f32x4){asc, asc, asc, asc}, bv[bj][1]);
                    if (Y_F8) { const f32x4 s0 = v0, s1 = v1; u32x2 w; w.x = pk4_fp8(s0[0], s0[1], s0[2], s0[3]); w.y = pk4_fp8(s1[0], s1[1], s1[2], s1[3]); *(u32x2*)((unsigned char*)yb + eoff + bj * HALF) = w; }
                    else { u32x4 w; w.x = cvt_pk_bf16(v0[0], v0[1]); w.y = cvt_pk_bf16(v0[2], v0[3]); w.z = cvt_pk_bf16(v1[0], v1[1]); w.w = cvt_pk_bf16(v1[2], v1[3]);
                    *(u32x4*)((bf16_t*)yb + eoff + bj * HALF) = w; } } }
    }
};
}

namespace moba {
constexpr int HD = 128, LD = 1024;
constexpr float SCALE = 0.08838834764831845f;
constexpr float THR = 8.f;
constexpr int NW = 8, QBLK = 32, KVBLK = 64, QB = NW * QBLK;
constexpr int SHM_V = KVBLK * HD * 2, SHM_K = KVBLK * HD * 2;
constexpr int G_OFF = 2 * SHM_V + 2 * SHM_K + NW * 64 * 4;
constexpr int LDS_ATT = G_OFF + 8192;

#define KSWZ(row, colB) ((row) * 256 + ((colB) ^ (((row) & 7) << 4)))
#define SBAR() __builtin_amdgcn_sched_barrier(0)
__device__ __forceinline__ int v_st(int k, int c) { const int kk = (k & ~0xC) | ((k & 4) << 1) | ((k & 8) >> 1); return ((kk >> 3) * 4 + (c >> 5)) * 512 + ((kk & 7) * 32 + (c & 31)) * 2; }
__device__ __forceinline__ int v_rd_base(int lane) { return ((lane & 3) << 3) | (((lane >> 2) & 3) << 6) | (((lane >> 4) & 1) << 5) | (((lane >> 5) & 1) << 8); }
constexpr int v_rd_off(int d0, int ks, int half) { return d0 * 512 + ks * 4096 + half * 2048; }
__device__ __forceinline__ int crow(int r, int hi) { return (r & 3) + 8 * (r >> 2) + 4 * hi; }
__device__ __forceinline__ unsigned cvtpk(float lo, float hi) { unsigned r; asm volatile("v_cvt_pk_bf16_f32 %0, %1, %2" : "=v"(r) : "v"(lo), "v"(hi)); return r; }
__device__ __forceinline__ bf16x8 load8(const bf16_t* p) { return *reinterpret_cast<const bf16x8*>(p); }
__device__ __forceinline__ void mask_tile(f32x16& p0, f32x16& p1, int dq) {
    const float NEG = -__builtin_inff();
#pragma unroll
    for (int r = 0; r < 16; ++r) {
        const int c = (r & 3) + 8 * (r >> 2);
        if (dq - c < 0) p0[r] = NEG;
        if (dq - c - 32 < 0) p1[r] = NEG;
    }
}
__device__ __forceinline__ void partialSM(f32x16& p0, f32x16& p1, float& m_reg, float& mn, float& alpha, bool keep = true) {
    float pmax = p0[0];
#pragma unroll
    for (int r = 1; r < 16; ++r) pmax = fmaxf(pmax, p0[r]);
#pragma unroll
    for (int r = 0; r < 16; ++r) pmax = fmaxf(pmax, p1[r]);
    { auto rr = __builtin_amdgcn_permlane32_swap(__float_as_uint(pmax), __float_as_uint(pmax), false, false);
      pmax = fmaxf(__uint_as_float(rr[0]), __uint_as_float(rr[1])); }
    pmax = keep ? pmax : -__builtin_inff();
    constexpr float C2 = 1.4426950408889634f * SCALE;
    if (__builtin_expect(__all((pmax - m_reg) * SCALE <= THR), 1)) { mn = m_reg; alpha = 1.f; }
    else { mn = fmaxf(m_reg, pmax); alpha = __builtin_amdgcn_exp2f((m_reg - mn) * C2); m_reg = mn; }
    const float mnL = keep ? -mn * C2 : -__builtin_inff();
#pragma unroll
    for (int r = 0; r < 16; ++r) p0[r] = fmaf(p0[r], C2, mnL);
#pragma unroll
    for (int r = 0; r < 16; ++r) p1[r] = fmaf(p1[r], C2, mnL);
#pragma unroll
    for (int r = 0; r < 16; ++r) p0[r] = __builtin_amdgcn_exp2f(p0[r]);
}
__device__ __forceinline__ void finishSM(f32x16& p0, f32x16& p1, float alpha, float& l_reg, bf16x8& pa0, bf16x8& pa1, bf16x8& pa2, bf16x8& pa3) {
#pragma unroll
    for (int r = 0; r < 16; ++r) p1[r] = __builtin_amdgcn_exp2f(p1[r]);
    float ps = 0;
#pragma unroll
    for (int r = 0; r < 16; ++r) ps += p0[r];
#pragma unroll
    for (int r = 0; r < 16; ++r) ps += p1[r];
    { auto rr = __builtin_amdgcn_permlane32_swap(__float_as_uint(ps), __float_as_uint(ps), false, false);
      ps = __uint_as_float(rr[0]) + __uint_as_float(rr[1]); }
    l_reg = l_reg * alpha + ps;
#define PK4(P, B_, OUT) do { unsigned a0 = cvtpk(P[B_+0], P[B_+1]), a1 = cvtpk(P[B_+2], P[B_+3]);                          \
        unsigned b0 = cvtpk(P[B_+4], P[B_+5]), b1 = cvtpk(P[B_+6], P[B_+7]);                                             \
        auto r0 = __builtin_amdgcn_permlane32_swap(a0, b0, false, false); auto r1 = __builtin_amdgcn_permlane32_swap(a1, b1, false, false); \
        u32x4 w = {r0[0], r1[0], r0[1], r1[1]}; OUT = *reinterpret_cast<bf16x8*>(&w); } while (0)
    PK4(p0, 0, pa0); PK4(p0, 8, pa1); PK4(p1, 0, pa2); PK4(p1, 8, pa3);
#undef PK4
}
template <int KB>
__device__ __forceinline__ void qkt(f32x16& p0, f32x16& p1, const char* K_lds, int r32, int hi, const bf16x8* qr) {
    p0 = f32x16{}; p1 = f32x16{};
    const char* kb[4];
#pragma unroll
    for (int dd = 0; dd < 4; ++dd) kb[dd] = K_lds + KB * SHM_K + KSWZ(r32, (dd * 16 + hi * 8) * 2);
#pragma unroll
    for (int d0 = 0; d0 < 8; ++d0) { const char* a = kb[d0 & 3] + (d0 >> 2) * 128;
        bf16x8 b0 = *reinterpret_cast<const bf16x8*>(a);
        bf16x8 b1 = *reinterpret_cast<const bf16x8*>(a + 32 * 256);
        p0 = __builtin_amdgcn_mfma_f32_32x32x16_bf16(b0, qr[d0], p0, 0, 0, 0);
        p1 = __builtin_amdgcn_mfma_f32_32x32x16_bf16(b1, qr[d0], p1, 0, 0, 0); }
}
template <int VB>
__device__ __forceinline__ void pv_tile(f32x16* o, int vb0, bf16x8 pa0, bf16x8 pa1, bf16x8 pa2, bf16x8 pa3) {
#define TRRD(dst, off) asm volatile("ds_read_b64_tr_b16 %0, %1 offset:%2" : "=&v"(dst) : "v"(vb0), "i"(off) : "memory")
#define PV_D0(d0) do { s16x4 l0, l1, l2, l3, h0, h1, h2, h3; constexpr int b_ = VB * SHM_V + v_rd_off(d0, 0, 0); \
        TRRD(l0, b_); TRRD(h0, b_ + 2048); TRRD(l1, b_ + 4096); TRRD(h1, b_ + 6144); TRRD(l2, b_ + 8192); TRRD(h2, b_ + 10240); TRRD(l3, b_ + 12288); TRRD(h3, b_ + 14336); \
        asm volatile("s_waitcnt lgkmcnt(0)" ::: "memory"); SBAR();   \
        o[d0] = __builtin_amdgcn_mfma_f32_32x32x16_bf16(pa0, (bf16x8){l0[0], l0[1], l0[2], l0[3], h0[0], h0[1], h0[2], h0[3]}, o[d0], 0, 0, 0);   \
        o[d0] = __builtin_amdgcn_mfma_f32_32x32x16_bf16(pa1, (bf16x8){l1[0], l1[1], l1[2], l1[3], h1[0], h1[1], h1[2], h1[3]}, o[d0], 0, 0, 0);   \
        o[d0] = __builtin_amdgcn_mfma_f32_32x32x16_bf16(pa2, (bf16x8){l2[0], l2[1], l2[2], l2[3], h2[0], h2[1], h2[2], h2[3]}, o[d0], 0, 0, 0);   \
        o[d0] = __builtin_amdgcn_mfma_f32_32x32x16_bf16(pa3, (bf16x8){l3[0], l3[1], l3[2], l3[3], h3[0], h3[1], h3[2], h3[3]}, o[d0], 0, 0, 0); } while (0)
    PV_D0(0); PV_D0(1); PV_D0(2); PV_D0(3);
#undef PV_D0
#undef TRRD
}

struct BlockRef { int qo, kvo, kmo, qb; };
struct Bases { const bf16_t* Q; const bf16_t* K; const bf16_t* V; bf16_t* O; const float* KS; };
__device__ __forceinline__ bf16x8 kmean8(const float* p, int lo) {
    const f32x4 a = *(const f32x4*)p * (1.0f / 256.0f), b = *(const f32x4*)(p + 4) * (1.0f / 256.0f);
    const float v[8] = {a[0], a[1], a[2], a[3], b[0], b[1], b[2], b[3]}; unsigned short o[8];
#pragma unroll
    for (int e = 0; e < 8; ++e) { const unsigned h = f2bf(v[e]); o[e] = (unsigned short)(lo ? f2bf(v[e] - __uint_as_float(h << 16)) : h); }
    return (bf16x8){(short)o[0], (short)o[1], (short)o[2], (short)o[3], (short)o[4], (short)o[5], (short)o[6], (short)o[7]};
}
struct Seam { bf16x8 qr[8]; bf16x8 st_v0, st_v1, st_k0, st_k1; };

#define ROW(p, k0, rr) ((p) + (size_t)((k0) + (rr)) * LD + sc)
#define VMW() asm volatile("s_waitcnt vmcnt(0)" ::: "memory")
#define VMWN(n) asm volatile("s_waitcnt vmcnt(%0)" :: "i"(n) : "memory")
#define SLOAD_H(Kp, Vp, k0) do { S.st_v0 = load8(ROW(Vp, k0, sr)); S.st_v1 = load8(ROW(Vp, k0, 32 + sr));              \
                         S.st_k0 = load8(ROW(Kp, k0, sr)); S.st_k1 = load8(ROW(Kp, k0, 32 + sr)); } while (0)
#define SWRITE_HK(bf) do { *(bf16x8*)(K_lds + (bf) * SHM_K + kws) = S.st_k0; *(bf16x8*)(K_lds + (bf) * SHM_K + kws + 32 * 256) = S.st_k1; } while (0)
#define SWRITE_HV(bf) do { *(bf16x8*)(V_lds + (bf) * SHM_V + vst0) = S.st_v0; *(bf16x8*)(V_lds + (bf) * SHM_V + vst1) = S.st_v1; } while (0)
#define SWRITE_H(bf) do { SWRITE_HV(bf); SWRITE_HK(bf); } while (0)
#define GLOAD(ref, tq) (kmean8(BP.KS + (size_t)(ref).kmo + (size_t)(((tq) & 255) >> 4) * LD + ((tq) & 15) * 8, (tq) >> 8))
#define GWRITE(val, tq) do { *(bf16x8*)(lds + G_OFF + ((tq) >> 8) * 4096 + KSWZ(((tq) & 255) >> 4, ((tq) & 15) * 16)) = (val); } while (0)

__device__ __forceinline__ void moba_prime(const Bases& BP, const BlockRef& cur, char* lds, Seam& S) {
    const int tid = opaque_tid(), wid = __builtin_amdgcn_readfirstlane(tid >> 6), lane = tid & 63, r32 = lane & 31, hi = lane >> 5;
    const int sr = tid >> 4, sc = (tid & 15) * 8, kws = KSWZ(sr, sc * 2); char* K_lds = lds + 2 * SHM_V;
#pragma unroll
    for (int d0 = 0; d0 < 8; ++d0) S.qr[d0] = load8(BP.Q + (size_t)cur.qo + (size_t)(wid * QBLK + r32) * LD + d0 * 16 + hi * 8);
    const bf16x8 gv = GLOAD(cur, tid);
    SLOAD_H(BP.K + (size_t)cur.kvo, BP.V + (size_t)cur.kvo, 0); VMW(); SWRITE_HK(0); GWRITE(gv, tid);
    __syncthreads();
}
__device__ __forceinline__ void moba_block(const Bases& BP, const BlockRef& cur, const BlockRef& nxt, char* lds, Seam& S) {
    int tid_ = threadIdx.x; asm volatile("" : "+v"(tid_));
    const int tid = tid_, wid = __builtin_amdgcn_readfirstlane(tid >> 6), lane = tid & 63, r32 = lane & 31, hi = lane >> 5;
    const int P0 = cur.qb * QB;
    const int NT = (cur.qb + 1) * 4;
    const int qlo = P0 + wid * QBLK, qm = qlo + r32 - 4 * hi;
    char* V_lds = lds; char* K_lds = lds + 2 * SHM_V;
    float* ws = (float*)(lds + 2 * SHM_V + 2 * SHM_K) + wid * 64; float* li_l = ws, * al_l = ws + 32;
    int sel;
    if (cur.qb <= 3) sel = (1 << cur.qb) - 1;
    else {
        f32x16 g = f32x16{};
        const char* gb = lds + G_OFF;
#pragma unroll
        for (int d0 = 0; d0 < 8; ++d0) { const int off = KSWZ(r32 & 15, (d0 * 16 + hi * 8) * 2);
            const bf16x8 ah = *reinterpret_cast<const bf16x8*>(gb + off), al = *reinterpret_cast<const bf16x8*>(gb + 4096 + off);
            g = __builtin_amdgcn_mfma_f32_32x32x16_bf16(ah, S.qr[d0], g, 0, 0, 0);
            g = __builtin_amdgcn_mfma_f32_32x32x16_bf16(al, S.qr[d0], g, 0, 0, 0); }
        float s[16];
#pragma unroll
        for (int r = 0; r < 8; ++r) { const float mine = g[r]; const float other = __shfl_xor(mine, 32);
            const int b0 = (r & 3) + 8 * (r >> 2);
            s[b0] = hi ? other : mine; s[b0 + 4] = hi ? mine : other; }
        sel = 0;
#pragma unroll
        for (int round = 0; round < 3; ++round) { float best = -__builtin_inff(); int bi = 0;
#pragma unroll
            for (int j = 0; j < 16; ++j) { const bool ok = (j < cur.qb) && !((sel >> j) & 1); const float v = ok ? s[j] : -__builtin_inff(); if (v > best) { best = v; bi = j; } }
            sel |= 1 << bi; }
    }
    float m_reg = -1e30f, l_reg = 0; f32x16 o[4] = {};
    const int sr = tid >> 4, sc = (tid & 15) * 8, vst0 = v_st(sr, sc), vst1 = v_st(32 + sr, sc), kws = KSWZ(sr, sc * 2);
    const int vb0 = (int)(uintptr_t)V_lds + v_rd_base(lane);
    const bf16_t* Kh = BP.K + (size_t)cur.kvo; const bf16_t* Vh = BP.V + (size_t)cur.kvo;
#define RESC(a) do { if (__any((a) < 1.f)) { if (hi == 0) al_l[r32] = (a); asm volatile("s_waitcnt lgkmcnt(0)" ::: "memory");              \
                     for (int d_ = 0; d_ < 4; ++d_) for (int r = 0; r < 16; ++r) o[d_][r] *= al_l[crow(r, hi)]; } } while (0)
#define KBASE(t) ((t) * KVBLK)
#define MASKT(P0_, P1_, t) do { const int kb_ = KBASE(t); if (kb_ >= P0 && kb_ + KVBLK - 1 > qlo) mask_tile(P0_, P1_, qm - kb_); } while (0)
#define KEEPT(t) ((KBASE(t) >= P0) || ((sel >> (KBASE(t) >> 8)) & 1))
    constexpr int NQL = 8;
#define SEAM_K0() do { VMWN(NQL); SWRITE_HK(0); SBAR(); } while (0)
    f32x16 pA0, pA1, pB0, pB1; float mnA, mnB, alA, alB; bf16x8 pa0, pa1, pa2, pa3;
    SWRITE_HV(0); SBAR();
    if (NT > 1) { SLOAD_H(Kh, Vh, KBASE(1)); }
    SBAR(); qkt<0>(pA0, pA1, K_lds, r32, hi, S.qr);
    MASKT(pA0, pA1, 0); partialSM(pA0, pA1, m_reg, mnA, alA, KEEPT(0));
    if (NT > 1) { VMW(); SWRITE_H(1); }
    __syncthreads();
#define HALF_STEP(PX0, PX1, mnX, alX, PY0, PY1, alY, t, KB, VB, SB) do {                                                      \
        SBAR(); qkt<KB>(PX0, PX1, K_lds, r32, hi, S.qr);                                             \
        finishSM(PY0, PY1, alY, l_reg, pa0, pa1, pa2, pa3); SBAR();                                                           \
        if ((t) + 1 < NT) { SLOAD_H(Kh, Vh, KBASE((t) + 1)); SBAR(); }                                               \
        pv_tile<VB>(o, vb0, pa0, pa1, pa2, pa3); MASKT(PX0, PX1, (t)); partialSM(PX0, PX1, m_reg, mnX, alX, KEEPT(t));                                        \
        __syncthreads();                                                                                                      \
        if ((t) + 1 < NT) { VMW(); SWRITE_H(SB); }                                                                          \
        RESC(alX); __syncthreads(); } while (0)
    for (int t = 1; t + 1 < NT; t += 2) {
        HALF_STEP(pB0, pB1, mnB, alB, pA0, pA1, alA, t, 1, 0, 0);
        HALF_STEP(pA0, pA1, mnA, alA, pB0, pB1, alB, t + 1, 0, 1, 1);
    }
    const bool even = (NT & 1) == 0;
    if (even) { SBAR(); qkt<1>(pB0, pB1, K_lds, r32, hi, S.qr); SBAR(); }
    SLOAD_H(BP.K + (size_t)nxt.kvo, BP.V + (size_t)nxt.kvo, 0); SBAR();
    int tz = threadIdx.x; asm volatile("" : "+v"(tz));
    const int widz = __builtin_amdgcn_readfirstlane(tz >> 6), r32z = tz & 31, hiz = (tz >> 5) & 1;
    { const bf16_t* qn = BP.Q + (size_t)nxt.qo + (size_t)(widz * QBLK + r32z) * LD + hiz * 8;
#pragma unroll
      for (int d0 = 0; d0 < 8; ++d0) S.qr[d0] = load8(qn + d0 * 16); }
    SBAR();
    finishSM(pA0, pA1, alA, l_reg, pa0, pa1, pa2, pa3); SBAR();
    pv_tile<0>(o, vb0, pa0, pa1, pa2, pa3);
    if (even) { MASKT(pB0, pB1, NT - 1); partialSM(pB0, pB1, m_reg, mnB, alB, KEEPT(NT - 1)); __syncthreads(); RESC(alB);
        finishSM(pB0, pB1, alB, l_reg, pa0, pa1, pa2, pa3); SBAR(); pv_tile<1>(o, vb0, pa0, pa1, pa2, pa3); }
    SBAR(); SEAM_K0();
    const bf16x8 gnext = GLOAD(nxt, tz);
    if (hiz == 0) li_l[r32z] = l_reg; asm volatile("s_waitcnt lgkmcnt(0)" ::: "memory");
    float rli[16];
#pragma unroll
    for (int r = 0; r < 16; ++r) rli[r] = __builtin_amdgcn_rcpf(li_l[crow(r, hiz)]);
#if FP8_OUT
    { const int lanez = tz & 63; char* ost = lds + LDS_ATT + widz * 4096;
#pragma unroll
      for (int r = 0; r < 16; ++r) { const int orow = (r & 3) + 8 * (r >> 2) + 4 * hiz; const float sc = rli[r] * YMIX_SC;
#pragma unroll
          for (int d0 = 0; d0 < 4; ++d0) { const float v = o[d0][r] * sc; *(unsigned char*)(ost + orow * 128 + d0 * 32 + r32z) = (unsigned char)__builtin_amdgcn_cvt_pk_fp8_f32(v, v, 0, false); } }
      asm volatile("s_waitcnt lgkmcnt(0)" ::: "memory");
      unsigned char* Og = (unsigned char*)BP.O + (size_t)cur.qo + (size_t)(widz * QBLK + (lanez >> 3)) * LD + (lanez & 7) * 16;
      u32x4 w4[4];
#pragma unroll
      for (int q4 = 0; q4 < 4; ++q4) w4[q4] = *(const u32x4*)(ost + ((lanez >> 3) + 8 * q4) * 128 + (lanez & 7) * 16);
#pragma unroll
      for (int q4 = 0; q4 < 4; ++q4) *(u32x4*)(Og + (size_t)(8 * q4) * LD) = w4[q4];
      asm volatile("s_waitcnt lgkmcnt(0)" ::: "memory"); }
#else
    bf16_t* Ow = BP.O + (size_t)cur.qo + (size_t)(widz * QBLK + 4 * hiz) * LD + r32z;
#pragma unroll
    for (int r = 0; r < 16; ++r) { const int orow = (r & 3) + 8 * (r >> 2);
#pragma unroll
        for (int d0 = 0; d0 < 4; ++d0) { const float v = o[d0][r] * rli[r];
            const float vn = __shfl_xor(v, 1);
            if ((r32z & 1) == 0) *(unsigned*)(Ow + (size_t)orow * LD + d0 * 32) = cvtpk(v, vn); } }
#endif
    GWRITE(gnext, tz);
    __syncthreads();
#undef RESC
#undef KBASE
#undef MASKT
#undef KEEPT
#undef SEAM_K0
#undef HALF_STEP
}
#undef ROW
#undef VMW
#undef VMWN
#undef SLOAD_H
#undef SWRITE_HK
#undef SWRITE_HV
#undef SWRITE_H
#undef GLOAD
#undef GWRITE

__device__ __forceinline__ bool item_of(int c, int G, int i, int& bh, int& x) {
    if (G == 256) { const int s = (c >> 3) + 32 * i; if (s >= 64) return false; bh = (c & 7) + 8 * (s >> 3); x = s & 7; return true; }
    const int L = c + i * G; if (L >= 512) return false; bh = L >> 3; x = L & 7; return true;
}
__device__ __forceinline__ BlockRef ref_of(int bh, int qb) {
    const int b = bh >> 3, h = bh & 7; BlockRef r;
    r.qo = (b * SEQ + qb * QB) * LD + h * HD; r.kvo = b * SEQ * LD + h * HD; r.kmo = b * 16 * LD + h * HD; r.qb = qb;
    return r;
}
__device__ __forceinline__ void attn_phase(char* lds, const Bases& BP, int G, int c) {
    int it = 0, bh, x; if (!item_of(c, G, 0, bh, x)) return;
    int pass = 0;
    BlockRef cur = ref_of(bh, x);
    Seam S;
    if (__builtin_amdgcn_readfirstlane((int)(threadIdx.x >> 8))) __builtin_amdgcn_s_setprio(1);
    moba_prime(BP, cur, lds, S);
    for (;;) {
        int bhn = bh, xn = x, passn = pass + 1, itn = it; bool last = false;
        if (pass == 1) { passn = 0; itn = it + 1; if (!item_of(c, G, itn, bhn, xn)) { last = true; bhn = bh; xn = x; passn = pass; itn = it; } }
        const BlockRef nxt = last ? cur : ref_of(bhn, passn ? 15 - xn : xn);
        moba_block(BP, cur, nxt, lds, S);
        if (last) break;
        cur = nxt; bh = bhn; x = xn; pass = passn; it = itn;
    }
    __builtin_amdgcn_s_setprio(0);
}
}

struct Args { const float* in[22]; float* out; unsigned char* ws; };

__device__ __forceinline__ int rowmap(int mode, int n) {
    if (mode == 1) { const int g = n >> 10, m = n & 1023; return ((m >> 7) << 8) + (g << 7) + (m & 127); }
    if (mode == 2) { if (n >= 2048) return n; const int d = n & 127, dd = d & 63; return (n & ~127) + ((dd >> 4) << 5) + (((dd >> 2) & 3) << 3) + ((d >> 6) << 2) + (d & 3); }
    return n;
}
struct CvItem { const float* W; bf16_t* WT; int N, ldk, koff, row_off, mode, kb, nb; float f8scale; };
__device__ __forceinline__ const float* arg_ptr(int k);
constexpr int CV_SMALL = 2 * 512 + 2 * 256 + 2 * 256 + 2 * 768 + 2 * 8 * 2 * 4;
constexpr int CV_MOE = 32 * 512 + 32 * 256;
__device__ __forceinline__ CvItem cv_small(unsigned char* ws, int r) {
    CvItem c; c.ldk = 1024; c.koff = 0; c.row_off = 0; c.mode = 0; c.f8scale = 0.f;
    constexpr int I_IN = 2 * 512, I_OUTR = 2 * 256, I_O = 2 * 256, I_QKV = 2 * 768;
    if (r < I_IN) { const int mat = r >> 9, rr = r & 511; c.W = arg_ptr(5) + (size_t)mat * 1024 * 2048; c.N = 2048; c.WT = (bf16_t*)(ws + WS_WIN) + (size_t)mat * 2048 * 1024; c.kb = rr >> 6; c.nb = rr & 63; if (FP8_IN) { c.f8scale = 32.0f; c.WT = (bf16_t*)(ws + WS_WIN + (size_t)mat * 2048 * 1024); } }
    else if ((r -= I_IN) < I_OUTR) { const int mat = r >> 8, rr = r & 255; c.W = arg_ptr(13) + (size_t)mat * 1024 * 1024; c.N = 1024; c.WT = (bf16_t*)(ws + WS_WOUT) + (size_t)(2 * mat) * 1024 * 1024; c.kb = rr >> 5; c.nb = rr & 31; if (FP8_OUT) { c.f8scale = 32.0f; c.WT = (bf16_t*)(ws + WS_WOUT + (size_t)(2 * mat) * 1024 * 1024); } }
    else if ((r -= I_OUTR) < I_O) { const int mat = r >> 8, rr = r & 255; c.W = arg_ptr(15) + (size_t)mat * 1024 * 1024; c.N = 1024; c.WT = (bf16_t*)(ws + WS_WOUT) + (size_t)(2 * mat + 1) * 1024 * 1024; c.kb = rr >> 5; c.nb = rr & 31; if (FP8_OUT) { c.f8scale = 32.0f; c.WT = (bf16_t*)(ws + WS_WOUT + (size_t)(2 * mat + 1) * 1024 * 1024); } }
    else if ((r -= I_O) < I_QKV) { const int mat = r / 768, rr = r % 768; c.W = arg_ptr(14) + (size_t)mat * 1024 * 3072; c.N = 3072; c.WT = (bf16_t*)(ws + WS_WQKV) + (size_t)mat * 3072 * 1024; c.kb = rr / 96; c.nb = rr % 96; c.mode = 2; if (FP8_QKV) { c.f8scale = 32.0f; c.WT = (bf16_t*)(ws + WS_WQKV + (size_t)mat * 3072 * 1024); } }
    else { r -= I_QKV; const int rr = r & 3, m2 = r >> 2, which = m2 & 1, h = (m2 >> 1) & 7, l = m2 >> 4;
        c.W = arg_ptr(which ? 10 : 8) + (size_t)(l * 8 + h) * 128 * 128; c.N = 128; c.WT = (bf16_t*)(ws + WS_WGATE) + (size_t)(l * 8 + h) * 256 * 128; c.ldk = 128; c.row_off = 128 * which; c.kb = 0; c.nb = rr; }
    return c;
}
__device__ __forceinline__ CvItem cv_moe(unsigned char* ws, int layer, int r) {
    CvItem c; c.ldk = 1024; c.koff = 0; c.row_off = 0; c.f8scale = 0.f;
    if (r < 32 * 512) { const int mat = layer * 32 + (r >> 9), rr = r & 511; c.W = arg_ptr(18) + (size_t)mat * 1024 * 2048; c.N = 2048; c.WT = (bf16_t*)(ws + WS_WGU) + (size_t)mat * 2048 * 1024; c.kb = rr >> 6; c.nb = rr & 63; c.mode = 1; if (FP8_GU) { c.f8scale = 32.0f; c.WT = (bf16_t*)(ws + WS_WGU + (size_t)mat * 2048 * 1024); } }
    else { r -= 32 * 512; const int mat = layer * 32 + (r >> 8), rr = r & 255; c.W = arg_ptr(20) + (size_t)mat * 1024 * 1024; c.N = 1024; c.WT = (bf16_t*)(ws + WS_WDN) + (size_t)mat * 1024 * 1024; c.kb = rr >> 5; c.nb = rr & 31; c.mode = 0; if (FP8_DN) { c.f8scale = 64.0f; c.WT = (bf16_t*)(ws + WS_WDN + (size_t)mat * 1024 * 1024); } }
    return c;
}
__device__ __forceinline__ void cv_load(const CvItem& c, int lane, f32x4 (&v)[16]) {
    const float* ub = c.W + (size_t)(128 * c.kb) * c.N + 32 * c.nb;
    const unsigned lo = ((unsigned)(lane >> 3) * (unsigned)c.N + 4u * (lane & 7)) * 4u;
#pragma unroll
    for (int i = 0; i < 16; ++i) v[i] = __builtin_nontemporal_load((const f32x4*)((const char*)(ub + (size_t)(8 * i) * c.N) + lo));
}
__device__ __forceinline__ void cv_put(int lane, const f32x4 (&v)[16], LAS float* scr) {
#pragma unroll
    for (int i = 0; i < 16; ++i) { LAS float* d = scr + i * 266 + (lane >> 3) * 33 + 4 * (lane & 7); d[0] = v[i][0]; d[1] = v[i][1]; d[2] = v[i][2]; d[3] = v[i][3]; }
    LDS_WAIT(); asm volatile("" ::: "memory");
}
__device__ __forceinline__ void cv_emit(const CvItem& c, int lane, LAS float* scr) {
    const int cc = lane & 15;
#pragma unroll
    for (int j = 0; j < 8; ++j) { const int n = (lane >> 4) + 4 * j; const LAS float* s = scr + cc * 266 + n;
        const unsigned eo = (unsigned)rowmap(c.mode, 32 * c.nb + n) * (unsigned)c.ldk + 8u * cc;
        if (c.f8scale != 0.f) { const float q = c.f8scale; u32x2 o; o.x = pk4_fp8(s[0 * 33] * q, s[1 * 33] * q, s[2 * 33] * q, s[3 * 33] * q); o.y = pk4_fp8(s[4 * 33] * q, s[5 * 33] * q, s[6 * 33] * q, s[7 * 33] * q);
            *(u32x2*)((unsigned char*)c.WT + ((size_t)c.row_off * c.ldk + c.koff + 128 * c.kb) + eo) = o; }
        else { u32x4 o; o.x = pk2(s[0 * 33], s[1 * 33]); o.y = pk2(s[2 * 33], s[3 * 33]); o.z = pk2(s[4 * 33], s[5 * 33]); o.w = pk2(s[6 * 33], s[7 * 33]);
            *(u32x4*)((unsigned char*)(c.WT + ((size_t)c.row_off * c.ldk + c.koff + 128 * c.kb)) + 2u * eo) = o; } }
    LDS_WAIT(); asm volatile("" ::: "memory");
}
__device__ __forceinline__ void cv_store(const CvItem& c, int lane, const f32x4 (&v)[16], LAS float* scr) { cv_put(lane, v, scr); cv_emit(c, lane, scr); }
__device__ __forceinline__ void cv8_cvt(float q, const f32x4 (&v)[16], unsigned (&w)[16]) {
#pragma unroll
    for (int i = 0; i < 16; ++i) { const f32x4 t = v[i] * q; w[i] = pk4_fp8(t[0], t[1], t[2], t[3]); }
}
__device__ __forceinline__ void cv8_put(int lane, const unsigned (&w)[16], LAS unsigned* scr) {
    LAS unsigned* d = scr + 32 * (lane >> 5) + 4 * (lane & 7) + ((lane >> 3) & 3);
#pragma unroll
    for (int i = 0; i < 16; ++i) d[160 * (i >> 1) + 64 * (i & 1)] = w[i];
    LDS_WAIT(); asm volatile("" ::: "memory");
}
__device__ __forceinline__ void cv8_emit(const CvItem& c, int lane, LAS unsigned* scr) {
    const int ng = lane & 7, kgg = lane >> 3;
    u32x4 r[4];
#pragma unroll
    for (int t = 0; t < 4; ++t) r[t] = *(const LAS u32x4*)(scr + 160 * kgg + 32 * t + 4 * ng);
    LDS_WAIT(); asm volatile("" ::: "memory");
    u32x4 o[4];
#pragma unroll
    for (int t = 0; t < 4; ++t) {
        const unsigned t0 = __builtin_amdgcn_perm(r[t][1], r[t][0], 0x05010400u), t1 = __builtin_amdgcn_perm(r[t][1], r[t][0], 0x07030602u);
        const unsigned t2 = __builtin_amdgcn_perm(r[t][3], r[t][2], 0x05010400u), t3 = __builtin_amdgcn_perm(r[t][3], r[t][2], 0x07030602u);
        o[0][t] = __builtin_amdgcn_perm(t2, t0, 0x05040100u); o[1][t] = __builtin_amdgcn_perm(t2, t0, 0x07060302u);
        o[2][t] = __builtin_amdgcn_perm(t3, t1, 0x05040100u); o[3][t] = __builtin_amdgcn_perm(t3, t1, 0x07060302u); }
    unsigned char* wb = (unsigned char*)c.WT + ((size_t)c.row_off * c.ldk + c.koff + 128 * c.kb);
#pragma unroll
    for (int j = 0; j < 4; ++j) { const unsigned eo = (unsigned)rowmap(c.mode, 32 * c.nb + 4 * ng + j) * (unsigned)c.ldk + 16u * kgg;
        *(u32x4*)(wb + eo) = o[j]; }
}
__device__ __forceinline__ void cv_moe_range(unsigned char* ws, LAS unsigned char* lds, int layer, int lo, int hi, int G, int wg = -1) {
    const int tid = opaque_tid(), lane = tid & 63, wave = __builtin_amdgcn_readfirstlane(tid >> 6);
    const int gw = (wg < 0 ? (int)blockIdx.x : wg) * 8 + wave, NGW = G * 8;
    int it = lo + gw; if (it >= hi) return;
    f32x4 vA[16], vB[16]; CvItem cA, cB, cE;
#define CV_LD(c, v, idx) do { const int i_ = (idx); const bool h_ = i_ < hi; c = cv_moe(ws, layer, h_ ? i_ : it); if (h_) cv_load(c, lane, v); } while (0)
    CV_LD(cA, vA, it); CV_LD(cB, vB, it + NGW);
#if FP8_GU && FP8_DN
    LAS unsigned* scr = (LAS unsigned*)(lds + wave * CV_SCR);
    unsigned w[16];
    for (;;) {
        cv8_cvt(cA.f8scale, vA, w); cE = cA; CV_LD(cA, vA, it + 2 * NGW); cv8_put(lane, w, scr); cv8_emit(cE, lane, scr); if (it + NGW >= hi) break;
        cv8_cvt(cB.f8scale, vB, w); cE = cB; CV_LD(cB, vB, it + 3 * NGW); cv8_put(lane, w, scr); cv8_emit(cE, lane, scr); if (it + 2 * NGW >= hi) break;
        it += 2 * NGW;
    }
#else
    LAS float* scr = (LAS float*)(lds + wave * CV_SCR);
    for (;;) {
        cv_put(lane, vA, scr); cE = cA; CV_LD(cA, vA, it + 2 * NGW); cv_emit(cE, lane, scr); if (it + NGW >= hi) break;
        cv_put(lane, vB, scr); cE = cB; CV_LD(cB, vB, it + 3 * NGW); cv_emit(cE, lane, scr); if (it + 2 * NGW >= hi) break;
        it += 2 * NGW;
    }
#endif
#undef CV_LD
}
__device__ __forceinline__ void cv_idle_slot(unsigned char* ws, LAS unsigned char* lds, int layer, int quota) {
    if (layer >= DEPTH) return;
    const int tid = opaque_tid(), lane = tid & 63, wave = __builtin_amdgcn_readfirstlane(tid >> 6);
    LAS float* scr = (LAS float*)(lds + wave * CV_SCR);
    unsigned* ctr = (unsigned*)(ws + WS_CTL) + 8192 + 64 * layer;
    for (int q = 0; q < quota; ++q) {
        unsigned it = 0; if (lane == 0) it = __hip_atomic_fetch_add(ctr, 2u, __ATOMIC_RELAXED, __HIP_MEMORY_SCOPE_AGENT);
        it = (unsigned)__builtin_amdgcn_readfirstlane((int)it);
        if (it >= (unsigned)CV_MOE) break;
        const CvItem c0 = cv_moe(ws, layer, (int)it), c1 = cv_moe(ws, layer, (int)it + 1);
        f32x4 v0[16], v1[16]; cv_load(c0, lane, v0); cv_load(c1, lane, v1);
        cv_store(c0, lane, v0, scr); cv_store(c1, lane, v1, scr);
    }
}
__device__ __forceinline__ void cv_cleanup(unsigned char* ws, LAS unsigned char* lds, int layer, int G) {
    unsigned done = __hip_atomic_load((unsigned*)(ws + WS_CTL) + 8192 + 64 * layer, __ATOMIC_RELAXED, __HIP_MEMORY_SCOPE_AGENT);
    done = (unsigned)__builtin_amdgcn_readfirstlane((int)done);
    if (done < (unsigned)CV_MOE) cv_moe_range(ws, lds, layer, (int)done, CV_MOE, G);
}

__device__ __forceinline__ void prologue_phase(LAS unsigned char* lds, int G) {
    unsigned char* ws = (unsigned char*)arg_ptr(23);
    const int tid = opaque_tid(), lane = tid & 63, wave = __builtin_amdgcn_readfirstlane(tid >> 6);
    LAS float* scr = (LAS float*)(lds + wave * CV_SCR);
    const int gw = blockIdx.x * 8 + wave, NGW = G * 8;
    for (int it = gw; it < CV_SMALL; it += NGW) { const CvItem c = cv_small(ws, it); f32x4 v[16]; cv_load(c, lane, v); cv_store(c, lane, v, scr); }
    cv_moe_range(ws, lds, 0, 0, CV_MOE, G);
    const size_t gt = (size_t)blockIdx.x * 512 + tid, NGT = (size_t)G * 512;
    { int4* rt4 = (int4*)(ws + WS_ROWTOK); for (size_t i = gt; i < (size_t)NE * RT_CAP / 4; i += NGT) rt4[i] = make_int4(0, 0, 0, 0); }
    const float* x = arg_ptr(0); bf16_t* xb = (bf16_t*)(ws + WS_XBF);
    for (size_t i0 = gt; i0 < (size_t)T * D / 8; i0 += 4 * NGT) { f32x4 v0[4], v1[4];
#pragma unroll
        for (int u = 0; u < 4; ++u) { const size_t i = i0 + u * NGT; if (i < (size_t)T * D / 8) { v0[u] = *(const f32x4*)(x + i * 8); v1[u] = *(const f32x4*)(x + i * 8 + 4); } }
#pragma unroll
        for (int u = 0; u < 4; ++u) { const size_t i = i0 + u * NGT; if (i < (size_t)T * D / 8) { u32x4 w; w.x = pk2(v0[u][0], v0[u][1]); w.y = pk2(v0[u][2], v0[u][3]); w.z = pk2(v1[u][0], v1[u][1]); w.w = pk2(v1[u][2], v1[u][3]); *(u32x4*)(xb + i * 8) = w;
            if (FP8_X) { u32x2 q; q.x = pk4_fp8(v0[u][0], v0[u][1], v0[u][2], v0[u][3]); q.y = pk4_fp8(v1[u][0], v1[u][1], v1[u][2], v1[u][3]); *(u32x2*)(ws + WS_XF8 + i * 8) = q; } } } }
}

__device__ __forceinline__ void conv_phase(const bf16_t* rec, bf16_t* ub, const float* cw, const float* cb, int G) {
    const int tid = opaque_tid(), cg = tid & 127, rs = tid >> 7;
    float w[4][8], bias[8];
#pragma unroll
    for (int j = 0; j < 4; ++j) { const f32x4 a0 = *(const f32x4*)(cw + j * D + cg * 8), a1 = *(const f32x4*)(cw + j * D + cg * 8 + 4);
#pragma unroll
        for (int e = 0; e < 4; ++e) { w[j][e] = a0[e]; w[j][4 + e] = a1[e]; } }
    { const f32x4 a0 = *(const f32x4*)(cb + cg * 8), a1 = *(const f32x4*)(cb + cg * 8 + 4);
#pragma unroll
      for (int e = 0; e < 4; ++e) { bias[e] = a0[e]; bias[4 + e] = a1[e]; } }
    for (int tile = blockIdx.x; tile < T / 128; tile += G) {
        const int t0 = tile * 128 + rs * 32; const bool seq_start = (t0 & (SEQ - 1)) == 0;
        float p[3][8];
#pragma unroll
        for (int k = 0; k < 3; ++k) { u32x4 v = (u32x4){0u, 0u, 0u, 0u}; if (!seq_start) v = *(const u32x4*)(rec + (size_t)(t0 - 3 + k) * D + cg * 8);
            p[k][0] = bflo(v.x); p[k][1] = bfhi(v.x); p[k][2] = bflo(v.y); p[k][3] = bfhi(v.y); p[k][4] = bflo(v.z); p[k][5] = bfhi(v.z); p[k][6] = bflo(v.w); p[k][7] = bfhi(v.w); }
        for (int r0 = 0; r0 < 32; r0 += 8) { u32x4 vin[8];
#pragma unroll
          for (int rr = 0; rr < 8; ++rr) vin[rr] = *(const u32x4*)(rec + (size_t)(t0 + r0 + rr) * D + cg * 8);
#pragma unroll
          for (int rr = 0; rr < 8; ++rr) { const int r = r0 + rr; const u32x4 v = vin[rr];
            float c[8] = {bflo(v.x), bfhi(v.x), bflo(v.y), bfhi(v.y), bflo(v.z), bfhi(v.z), bflo(v.w), bfhi(v.w)}; float o[8];
#pragma unroll
            for (int e = 0; e < 8; ++e) { o[e] = bias[e] + w[0][e] * p[0][e] + w[1][e] * p[1][e] + w[2][e] * p[2][e] + w[3][e] * c[e]; p[0][e] = p[1][e]; p[1][e] = p[2][e]; p[2][e] = c[e]; }
            u32x4 ow; ow.x = pk2(o[0], o[1]); ow.y = pk2(o[2], o[3]); ow.z = pk2(o[4], o[5]); ow.w = pk2(o[6], o[7]);
            *(u32x4*)(ub + (size_t)(t0 + r) * D + cg * 8) = ow; } }
    }
}

__device__ __forceinline__ void scan1_phase(const bf16_t* la, const bf16_t* bb, float* agg, int G) {
    const int tid = opaque_tid();
    for (int unit = blockIdx.x; unit < 256; unit += G) {
        const size_t base = (size_t)unit * 128 * D + 2 * tid;
        float h0 = 0.f, h1 = 0.f, s0 = 0.f, s1 = 0.f;
        for (int t0 = 0; t0 < 128; t0 += 32) { unsigned lw[32], bw[32];
#pragma unroll
            for (int t = 0; t < 32; ++t) { lw[t] = *(const unsigned*)(la + base + (size_t)(t0 + t) * D); bw[t] = FP8_SCAN ? (unsigned)*(const unsigned short*)((const unsigned char*)bb + base + (size_t)(t0 + t) * D) : *(const unsigned*)(bb + base + (size_t)(t0 + t) * D); }
#pragma unroll
            for (int t = 0; t < 32; ++t) { const float l0 = bflo(lw[t]), l1 = bfhi(lw[t]); float b0, b1;
                if (FP8_SCAN) { const f32x2 b2 = __builtin_amdgcn_cvt_pk_f32_fp8((int)bw[t], false); b0 = b2[0]; b1 = b2[1]; } else { b0 = bflo(bw[t]); b1 = bfhi(bw[t]); }
                h0 = __expf(l0) * h0 + b0; h1 = __expf(l1) * h1 + b1; s0 += l0; s1 += l1; } }
        *(f32x4*)(agg + ((size_t)unit * D + 2 * tid) * 2) = (f32x4){__expf(s0), h0, __expf(s1), h1};
    }
}
__device__ __forceinline__ void scan2_phase(const bf16_t* la, const bf16_t* bb, const float* agg, const bf16_t* gg, bf16_t* y, int G) {
    const int tid = opaque_tid();
    for (int unit = blockIdx.x; unit < 256; unit += G) {
        const int chunk = unit & 31; const size_t base = (size_t)unit * 128 * D + 2 * tid;
        float h0 = 0.f, h1 = 0.f;
        const float* ag = agg + ((size_t)(unit - chunk) * D + 2 * tid) * 2;
#pragma unroll 8
        for (int jc = 0; jc < chunk; ++jc) { const f32x4 a = *(const f32x4*)(ag + (size_t)jc * D * 2); h0 = a[0] * h0 + a[1]; h1 = a[2] * h1 + a[3]; }
        for (int t0 = 0; t0 < 128; t0 += 16) { unsigned lw[16], bw[16], gw[16];
#pragma unroll
            for (int t = 0; t < 16; ++t) { lw[t] = *(const unsigned*)(la + base + (size_t)(t0 + t) * D);
                if (FP8_SCAN) { bw[t] = *(const unsigned short*)((const unsigned char*)bb + base + (size_t)(t0 + t) * D); gw[t] = *(const unsigned short*)((const unsigned char*)gg + base + (size_t)(t0 + t) * D); }
                else { bw[t] = *(const unsigned*)(bb + base + (size_t)(t0 + t) * D); gw[t] = *(const unsigned*)(gg + base + (size_t)(t0 + t) * D); } }
#pragma unroll
            for (int t = 0; t < 16; ++t) {
#if FP8_SCAN
                { const f32x2 b2 = __builtin_amdgcn_cvt_pk_f32_fp8((int)bw[t], false), g2 = __builtin_amdgcn_cvt_pk_f32_fp8((int)gw[t], false);
                  h0 = __expf(bflo(lw[t])) * h0 + b2[0]; h1 = __expf(bfhi(lw[t])) * h1 + b2[1];
                  *(unsigned short*)((unsigned char*)y + base + (size_t)(t0 + t) * D) = (unsigned short)__builtin_amdgcn_cvt_pk_fp8_f32(h0 * g2[0] * (YMIX_SC / (SCAN_SC * SCAN_SC)), h1 * g2[1] * (YMIX_SC / (SCAN_SC * SCAN_SC)), 0, false); }
                continue;
#endif
                h0 = __expf(bflo(lw[t])) * h0 + bflo(bw[t]); h1 = __expf(bfhi(lw[t])) * h1 + bfhi(bw[t]);
                if (FP8_OUT) *(unsigned short*)((unsigned char*)y + base + (size_t)(t0 + t) * D) = (unsigned short)__builtin_amdgcn_cvt_pk_fp8_f32(h0 * bflo(gw[t]) * YMIX_SC, h1 * bfhi(gw[t]) * YMIX_SC, 0, false);
                else *(unsigned*)(y + base + (size_t)(t0 + t) * D) = pk2(h0 * bflo(gw[t]), h1 * bfhi(gw[t])); } }
    }
}

__device__ __forceinline__ float half_max_fast(float v) {
    v = fmaxf(v, dppf<0xB1>(v)); v = fmaxf(v, dppf<0x4E>(v)); v = fmaxf(v, dppf<0x141>(v)); v = fmaxf(v, dppf<0x140>(v));
    { auto r = __builtin_amdgcn_permlane16_swap(__float_as_uint(v), __float_as_uint(v), false, false); v = fmaxf(__uint_as_float(r[0]), __uint_as_float(r[1])); }
    return v;
}
__device__ __forceinline__ void ln1_router_mfma_phase(LAS unsigned char* lds, const bf16_t* z, const float* g1, const float* b1, const float* wrt, const float* brt,
                                                      float* stats, unsigned char* x1f8, float* tokg, unsigned* gcnt, int* row_tok, int* pos_out, int G) {
    const int tid = opaque_tid(), lane = tid & 63, wave = __builtin_amdgcn_readfirstlane(tid >> 6);
    constexpr int RS = 2064;
    LAS unsigned char* XH = lds; LAS unsigned char* XL = lds + 16 * RS; LAS float* PART = (LAS float*)(lds + 32 * RS);
    LAS int* hist = (LAS int*)(lds + MISC_HIST);
    LAS int* tokl = (LAS int*)(lds + 32 * RS + 16896); LAS int* sBase = tokl + 512; LAS int* wcnt = sBase + 32;
    bf16x8 Bh[4][2], Bl[4][2];
    { const int n = lane & 15, kg = lane >> 4;
#pragma unroll
      for (int c = 0; c < 4; ++c)
#pragma unroll
          for (int h = 0; h < 2; ++h) { float wv[8];
#pragma unroll
              for (int j = 0; j < 8; ++j) wv[j] = wrt[(size_t)(128 * wave + 32 * c + 8 * kg + j) * NE + 16 * h + n];
#pragma unroll
              for (int j = 0; j < 8; ++j) { const unsigned hb = f2bf(wv[j]); Bh[c][h][j] = (short)hb; Bl[c][h][j] = (short)f2bf(wv[j] - __uint_as_float(hb << 16)); } } }
    f32x4 gv[4], bv[4];
#pragma unroll
    for (int i = 0; i < 4; ++i) { gv[i] = *(const f32x4*)(g1 + 4 * lane + 256 * i); bv[i] = *(const f32x4*)(b1 + 4 * lane + 256 * i); }
    const float bias_e = brt[lane & 31];
    for (int tile = blockIdx.x; tile < T / 128; tile += G) {
        if (tid < 32) hist[tid] = 0;
        __syncthreads();
        const int rb = tile * 128 + 2 * wave;
        u32x2 nv[2][4];
#pragma unroll
        for (int q = 0; q < 2; ++q)
#pragma unroll
            for (int i = 0; i < 4; ++i) nv[q][i] = *(const u32x2*)(z + (size_t)(rb + q) * D + 4 * lane + 256 * i);
        for (int st = 0; st < 8; ++st) {
            f32x4 v[2][4];
#pragma unroll
            for (int q = 0; q < 2; ++q)
#pragma unroll
                for (int i = 0; i < 4; ++i) v[q][i] = (f32x4){bflo(nv[q][i].x), bfhi(nv[q][i].x), bflo(nv[q][i].y), bfhi(nv[q][i].y)};
            { const int sn = (st < 7 ? st + 1 : st);
#pragma unroll
              for (int q = 0; q < 2; ++q)
#pragma unroll
                  for (int i = 0; i < 4; ++i) nv[q][i] = *(const u32x2*)(z + (size_t)(rb + 16 * sn + q) * D + 4 * lane + 256 * i); }
#pragma unroll
            for (int q = 0; q < 2; ++q) { const int row = rb + 16 * st + q; float s = 0.f;
#pragma unroll
                for (int i = 0; i < 4; ++i) s += (v[q][i][0] + v[q][i][1]) + (v[q][i][2] + v[q][i][3]);
                const float mean = wave_sum_fast(s) * (1.0f / D); float qq = 0.f;
#pragma unroll
                for (int i = 0; i < 4; ++i) { v[q][i] = v[q][i] - mean; qq += (v[q][i][0] * v[q][i][0] + v[q][i][1] * v[q][i][1]) + (v[q][i][2] * v[q][i][2] + v[q][i][3] * v[q][i][3]); }
                const float rstd = 1.0f / sqrtf(wave_sum_fast(qq) * (1.0f / D) + LN_EPS);
                if (lane == 0) *(f32x2*)(stats + (size_t)row * 2) = (f32x2){mean, rstd};
                LAS unsigned char* xh = XH + (2 * wave + q) * RS + 8 * lane; LAS unsigned char* xl = XL + (2 * wave + q) * RS + 8 * lane;
#pragma unroll
                for (int i = 0; i < 4; ++i) { v[q][i] = v[q][i] * rstd * gv[i] + bv[i];
                    *(unsigned*)(x1f8 + (size_t)row * D + 4 * lane + 256 * i) = pk4_fp8(v[q][i][0], v[q][i][1], v[q][i][2], v[q][i][3]);
                    u32x2 hw; hw.x = cvt_pk_bf16(v[q][i][0], v[q][i][1]); hw.y = cvt_pk_bf16(v[q][i][2], v[q][i][3]);
                    u32x2 lw; lw.x = cvt_pk_bf16(v[q][i][0] - __uint_as_float(hw.x << 16), v[q][i][1] - __uint_as_float(hw.x & 0xffff0000u));
                    lw.y = cvt_pk_bf16(v[q][i][2] - __uint_as_float(hw.y << 16), v[q][i][3] - __uint_as_float(hw.y & 0xffff0000u));
                    *(LAS u32x2*)(xh + 512 * i) = hw; *(LAS u32x2*)(xl + 512 * i) = lw; } }
            __syncthreads();
            f32x4 acc[2] = {(f32x4){0.f, 0.f, 0.f, 0.f}, (f32x4){0.f, 0.f, 0.f, 0.f}};
            { const int aoff = (lane & 15) * RS + (128 * wave + 8 * (lane >> 4)) * 2;
#pragma unroll
              for (int c = 0; c < 4; ++c) { const bf16x8 ah = *(const LAS bf16x8*)(XH + aoff + 64 * c), al = *(const LAS bf16x8*)(XL + aoff + 64 * c);
#pragma unroll
                  for (int h = 0; h < 2; ++h) { acc[h] = __builtin_amdgcn_mfma_f32_16x16x32_bf16(ah, Bh[c][h], acc[h], 0, 0, 0);
                      acc[h] = __builtin_amdgcn_mfma_f32_16x16x32_bf16(al, Bh[c][h], acc[h], 0, 0, 0); acc[h] = __builtin_amdgcn_mfma_f32_16x16x32_bf16(ah, Bl[c][h], acc[h], 0, 0, 0); } } }
#pragma unroll
            for (int h = 0; h < 2; ++h)
#pragma unroll
                for (int r = 0; r < 4; ++r) PART[(wave * 16 + 4 * (lane >> 4) + r) * 33 + 16 * h + (lane & 15)] = acc[h][r];
            __syncthreads();
            float lv = bias_e;
#pragma unroll
            for (int w2 = 0; w2 < 8; ++w2) lv += PART[(w2 * 16 + 2 * wave + (lane >> 5)) * 33 + (lane & 31)];
            float tv[4]; int ti[4];
#pragma unroll
            for (int k = 0; k < 4; ++k) { const float m = half_max_fast(lv); const unsigned long long bl = __ballot(lv == m);
                const int i0 = __ffs((int)(unsigned)bl) - 1, i1 = __ffs((int)(unsigned)(bl >> 32)) - 1; const int idx = (lane >> 5) ? i1 : i0;
                tv[k] = m; ti[k] = idx; if ((lane & 31) == idx) lv = -__builtin_inff(); }
            if ((lane & 31) == 0) { const int row = rb + 16 * st + (lane >> 5);
                const float e1 = __expf(tv[1] - tv[0]), e2 = __expf(tv[2] - tv[0]), e3 = __expf(tv[3] - tv[0]); const float inv = 1.0f / (1.0f + e1 + e2 + e3);
                *(LAS v4i_t*)(tokl + (16 * st + 2 * wave + (lane >> 5)) * 4) = (v4i_t){ti[0], ti[1], ti[2], ti[3]};
                *(f32x4*)(tokg + (size_t)row * 4) = (f32x4){inv, e1 * inv, e2 * inv, e3 * inv};
#pragma unroll
                for (int k = 0; k < 4; ++k) __hip_atomic_fetch_add(hist + ti[k], 1, __ATOMIC_RELAXED, __HIP_MEMORY_SCOPE_WORKGROUP); }
        }
        __syncthreads();
        if (tid < 32) sBase[tid] = (int)__hip_atomic_fetch_add(gcnt + tid, (unsigned)hist[tid], __ATOMIC_RELAXED, __HIP_MEMORY_SCOPE_AGENT);
        { const int token = tile * 128 + (tid >> 2), k = tid & 3; const int e = tokl[tid];
          int myrank = 0;
          for (int ee = 0; ee < 32; ++ee) { const unsigned long long m = __ballot(e == ee); if (e == ee) myrank = __popcll(m & ((1ull << lane) - 1ull)); if (lane == 0) wcnt[ee * 8 + wave] = __popcll(m); }
          __syncthreads();
          int wpre = 0;
          for (int w = 0; w < wave; ++w) wpre += wcnt[e * 8 + w];
          const int slot = sBase[e] + wpre + myrank;
          row_tok[e * RT_CAP + slot] = token; pos_out[(size_t)token * 4 + k] = (e << 20) | slot; }
        __syncthreads();
    }
}

__device__ __forceinline__ void build_tfirst(LAS int* tfirst, const unsigned* gcnt) {
    const int tid = opaque_tid();
    if (tid < 64) { const int c = (tid < 32) ? (int)gcnt[tid] : 0; const int tiles = (c + 255) >> 8; int incl = tiles;
#pragma unroll
        for (int off = 1; off < 32; off <<= 1) { const int n = __shfl_up(incl, off); if (tid >= off) incl += n; }
        if (tid < 32) tfirst[tid] = incl - tiles; if (tid == 31) tfirst[32] = incl; }
    __syncthreads();
}
__device__ __forceinline__ int build_tile_e(LAS unsigned char* tile_e, LAS int* tfirst, const unsigned* gcnt) {
    build_tfirst(tfirst, gcnt);
    const int tid = opaque_tid(); const int n_rt = tfirst[32];
    for (int rt = tid; rt < n_rt; rt += 512) { int e = 0; for (int q = 1; q < 32; ++q) e += (rt >= tfirst[q]) ? 1 : 0; tile_e[rt] = (unsigned char)e; }
    __syncthreads();
    return n_rt;
}

__device__ __forceinline__ void combine_ln2_phase(const bf16_t* x1b, const void* ybv, const int* pos_out, const float* tokg, const float* g2, const float* b2, float* outf, bf16_t* outb, unsigned char* outf8, int G,
                                                  const bf16_t* zb, const float* g1, const float* b1, LAS unsigned char* lds, const unsigned* gcnt) {
    const int tid = opaque_tid(), lane = tid & 63, wave = __builtin_amdgcn_readfirstlane(tid >> 6);
    LAS int* tfirst = (LAS int*)lds; build_tfirst(tfirst, gcnt);
    f32x4 gv[4], bv[4], g1v[4], b1v[4];
#pragma unroll
    for (int i = 0; i < 4; ++i) { gv[i] = *(const f32x4*)(g2 + 16 * lane + 4 * i); bv[i] = *(const f32x4*)(b2 + 16 * lane + 4 * i);
        g1v[i] = *(const f32x4*)(g1 + 16 * lane + 4 * i) * ALPHA; b1v[i] = *(const f32x4*)(b1 + 16 * lane + 4 * i) * ALPHA; }
    static_assert(X1_RECOMPUTE && Y_F8, "this combine reads the bf16 z + LayerNorm1 statistics and fp8 expert outputs");
    const unsigned char* yb = (const unsigned char*)ybv;
    const int first = blockIdx.x * 8 + wave, stride = G * 8;
    for (int base = first; base < T; base += stride * 64) {
        int nrow = (T - base + stride - 1) / stride; if (nrow > 64) nrow = 64;
        int4 ps = make_int4(0, 0, 0, 0); f32x4 gt = (f32x4){0.f, 0.f, 0.f, 0.f}; f32x2 st = (f32x2){0.f, 0.f};
        if (lane < nrow) { const size_t rw = (size_t)(base + lane * stride); ps = *(const int4*)(pos_out + rw * 4);
            ps.x = (tfirst[ps.x >> 20] << 8) + (ps.x & 0xFFFFF); ps.y = (tfirst[ps.y >> 20] << 8) + (ps.y & 0xFFFFF); ps.z = (tfirst[ps.z >> 20] << 8) + (ps.z & 0xFFFFF); ps.w = (tfirst[ps.w >> 20] << 8) + (ps.w & 0xFFFFF);
            gt = *(const f32x4*)(tokg + rw * 4); st = *(const f32x2*)((const float*)x1b + rw * 2); }
        u32x4 nz[2], ny[4];
#define CMB_LOAD(i_) do { const int row_ = base + (i_) * stride; \
            const int p0_ = __builtin_amdgcn_readlane(ps.x, (i_)), p1_ = __builtin_amdgcn_readlane(ps.y, (i_)), p2_ = __builtin_amdgcn_readlane(ps.z, (i_)), p3_ = __builtin_amdgcn_readlane(ps.w, (i_)); \
            nz[0] = *(const u32x4*)(zb + (size_t)row_ * D + 16 * lane); nz[1] = *(const u32x4*)(zb + (size_t)row_ * D + 16 * lane + 8); \
            ny[0] = *(const u32x4*)(yb + (size_t)p0_ * D + 16 * lane); ny[1] = *(const u32x4*)(yb + (size_t)p1_ * D + 16 * lane); \
            ny[2] = *(const u32x4*)(yb + (size_t)p2_ * D + 16 * lane); ny[3] = *(const u32x4*)(yb + (size_t)p3_ * D + 16 * lane); } while (0)
        CMB_LOAD(0);
        for (int it = 0; it < nrow; ++it) {
            const int row = base + it * stride;
            const float g0 = __uint_as_float(__builtin_amdgcn_readlane(__float_as_uint(gt[0]), it)), g1_ = __uint_as_float(__builtin_amdgcn_readlane(__float_as_uint(gt[1]), it)),
                        g2_ = __uint_as_float(__builtin_amdgcn_readlane(__float_as_uint(gt[2]), it)), g3_ = __uint_as_float(__builtin_amdgcn_readlane(__float_as_uint(gt[3]), it));
            const float gk[4] = {g0 * (1.0f / 16.0f), g1_ * (1.0f / 16.0f), g2_ * (1.0f / 16.0f), g3_ * (1.0f / 16.0f)};
            const float mean1 = __uint_as_float(__builtin_amdgcn_readlane(__float_as_uint(st[0]), it)), rstd1 = __uint_as_float(__builtin_amdgcn_readlane(__float_as_uint(st[1]), it));
            f32x4 v[4]; float s = 0.f;
#pragma unroll
            for (int i = 0; i < 4; ++i) { const unsigned w0 = nz[i >> 1][(i & 1) * 2], w1 = nz[i >> 1][(i & 1) * 2 + 1];
                const f32x4 xin = (f32x4){bflo(w0), bfhi(w0), bflo(w1), bfhi(w1)};
                v[i] = ((xin - mean1) * rstd1) * g1v[i] + b1v[i];
#pragma unroll
                for (int k = 0; k < 4; ++k) { const f32x2 lo = __builtin_amdgcn_cvt_pk_f32_fp8((int)ny[k][i], false), hi = __builtin_amdgcn_cvt_pk_f32_fp8((int)ny[k][i], true);
                    v[i][0] += gk[k] * lo[0]; v[i][1] += gk[k] * lo[1]; v[i][2] += gk[k] * hi[0]; v[i][3] += gk[k] * hi[1]; }
                s += (v[i][0] + v[i][1]) + (v[i][2] + v[i][3]); }
            { const int itn = (it + 1 < nrow) ? it + 1 : it; CMB_LOAD(itn); }
            const float mean = wave_sum_fast(s) * (1.0f / D); float q = 0.f;
#pragma unroll
            for (int i = 0; i < 4; ++i) { v[i] = v[i] - mean; q += (v[i][0] * v[i][0] + v[i][1] * v[i][1]) + (v[i][2] * v[i][2] + v[i][3] * v[i][3]); }
            const float rstd = 1.0f / sqrtf(wave_sum_fast(q) * (1.0f / D) + LN_EPS);
#pragma unroll
            for (int i = 0; i < 4; ++i) v[i] = v[i] * rstd * gv[i] + bv[i];
            if (outf) {
#pragma unroll
                for (int i = 0; i < 4; ++i) *(f32x4*)(outf + (size_t)row * D + 16 * lane + 4 * i) = v[i]; }
            else { u32x4 w0, w1; w0.x = pk2(v[0][0], v[0][1]); w0.y = pk2(v[0][2], v[0][3]); w0.z = pk2(v[1][0], v[1][1]); w0.w = pk2(v[1][2], v[1][3]);
                w1.x = pk2(v[2][0], v[2][1]); w1.y = pk2(v[2][2], v[2][3]); w1.z = pk2(v[3][0], v[3][1]); w1.w = pk2(v[3][2], v[3][3]);
                *(u32x4*)(outb + (size_t)row * D + 16 * lane) = w0; *(u32x4*)(outb + (size_t)row * D + 16 * lane + 8) = w1;
                u32x4 f8; f8.x = pk4_fp8(v[0][0], v[0][1], v[0][2], v[0][3]); f8.y = pk4_fp8(v[1][0], v[1][1], v[1][2], v[1][3]); f8.z = pk4_fp8(v[2][0], v[2][1], v[2][2], v[2][3]); f8.w = pk4_fp8(v[3][0], v[3][1], v[3][2], v[3][3]);
                *(u32x4*)(outf8 + (size_t)row * D + 16 * lane) = f8; }
        }
#undef CMB_LOAD
    }
}

#ifndef PH_MASK
#define PH_MASK 0xFFFFFF
#endif
#ifndef NCONV
#define NCONV 32
#endif
#ifndef DUP_MASK
#define DUP_MASK 0
#endif
#define PH(b) if (PH_MASK & (1u << (b))) for (int rep_ = 0; rep_ < (((DUP_MASK >> (b)) & 1) ? 2 : 1); ++rep_)
#define CAS __attribute__((address_space(4)))
__device__ __forceinline__ const float* arg_ptr(int k) {
    const CAS char* kp = (const CAS char*)__builtin_amdgcn_kernarg_segment_ptr();
    asm volatile("" : "+s"(kp));
    return *(const float* const CAS*)(kp + 8 * k);
}
#define AIN(k) arg_ptr(k)
#define WSP() ((unsigned char*)arg_ptr(23))
#define OUTP() ((float*)arg_ptr(22))

__device__ __forceinline__ int opaque_s(int v) { asm volatile("" : "+s"(v)); return v; }
__device__ __forceinline__ LAS unsigned char* opaque_lds(LAS unsigned char* p) { unsigned v = (unsigned)(size_t)p; asm volatile("" : "+s"(v)); return (LAS unsigned char*)(size_t)v; }
#define PHASE_ENV unsigned char* ws = WSP(); LAS unsigned char* ldsp = opaque_lds((LAS unsigned char*)lds_raw); const int Gp = opaque_s((int)gridDim.x); const int cp = opaque_s((int)blockIdx.x); (void)ws; (void)ldsp; (void)Gp; (void)cp
#define GCNT(ws_, layer_) ((unsigned*)((ws_) + WS_CTL) + 9216 + 64 * (layer_))
#define GRID_BAR() do { XcdBarrier b_; b_.bar = (unsigned*)(WSP() + WS_CTL); b_.x = xb_xcc_id(); b_.st = (volatile LAS unsigned*)(opaque_lds((LAS unsigned char*)lds_raw) + MISC_OFF); xcd_barrier(b_); } while (0)

__global__ void __launch_bounds__(512, 2) fwd_kernel(Args a) {
    extern __shared__ __attribute__((aligned(16))) unsigned char lds_raw[];
    __builtin_amdgcn_s_setreg(1 | (23 << 6), 1);
    { LAS unsigned char* lds0 = (LAS unsigned char*)lds_raw; const int tid0 = threadIdx.x;
      for (int u = tid0; u < (LDS_BYTES - MISC_OFF) / 4; u += 512) ((LAS unsigned*)(lds0 + MISC_OFF))[u] = 0u;
      __syncthreads();
      (void)xcd_barrier_post((unsigned*)(WSP() + WS_CTL), (volatile LAS unsigned*)(lds0 + MISC_OFF)); }

    PH(0) { PHASE_ENV; prologue_phase(ldsp, Gp); }
    GRID_BAR();

    for (int layer = 0; layer < DEPTH; ++layer) {
        const int j = layer >> 1;
        if ((layer & 1) == 0) {
            PH(1) { PHASE_ENV; pg8::TileOrderT<8> S; S.init(T / 256, 8, Gp, cp);
              pg8::SrcDenseT<FP8_IN != 0> X{(const char*)(ws + (FP8_IN ? WS_XF8 : WS_XBF)), (const char*)(ws + WS_WIN) + (size_t)j * 2048 * 1024 * (FP8_IN ? 1 : 2), D, D};
              pg8::EpiIn E{(bf16_t*)(ws + WS_GG), FP8_IN ? (1.0f / 32.0f) : 1.0f};
              pg8::gemm_phase(ldsp, opaque_s(D), S, X, E); }
            GRID_BAR();
            PH(2) { PHASE_ENV; conv_phase((const bf16_t*)(ws + WS_REC), (bf16_t*)(ws + WS_U), AIN(6) + (size_t)j * 4 * D, AIN(7) + (size_t)j * D, Gp); }
            GRID_BAR();
            PH(3) { PHASE_ENV; pg8::TileOrderT<8> S; S.init(T / 256, 8, Gp, cp);
              pg8::SrcGates X{(const char*)(ws + WS_U), (const char*)((bf16_t*)(ws + WS_WGATE) + (size_t)j * 8 * 256 * 128), D};
              pg8::EpiGates E{(bf16_t*)(ws + WS_LA), (bf16_t*)(ws + WS_BB), (const bf16_t*)(ws + WS_U), AIN(9) + (size_t)j * D, AIN(11) + (size_t)j * D, AIN(12) + (size_t)j * D};
              pg8::gemm_phase(ldsp, opaque_s(128), S, X, E); }
            GRID_BAR();
            PH(4) { PHASE_ENV; scan1_phase((const bf16_t*)(ws + WS_LA), (const bf16_t*)(ws + WS_BB), (float*)(ws + WS_AGG), Gp); }
            GRID_BAR();
            PH(4) { PHASE_ENV; scan2_phase((const bf16_t*)(ws + WS_LA), (const bf16_t*)(ws + WS_BB), (const float*)(ws + WS_AGG), (const bf16_t*)(ws + WS_GG), (bf16_t*)(ws + WS_YMIX), Gp); }
            GRID_BAR();
        } else {
            PH(5) { PHASE_ENV; pg8::TileOrderT<12> S; S.init(T / 256, 12, Gp, cp);
              pg8::SrcDenseT<FP8_QKV != 0> X{(const char*)(ws + (FP8_QKV ? WS_XF8 : WS_XBF)), (const char*)(ws + WS_WQKV) + (size_t)j * 3072 * 1024 * (FP8_QKV ? 1 : 2), D, D};
              pg8::EpiQKV E{};
              pg8::gemm_phase(ldsp, opaque_s(D), S, X, E); }
            GRID_BAR();
            PH(7) { PHASE_ENV;
              const moba::Bases BP{(const bf16_t*)(ws + WS_Q), (const bf16_t*)(ws + WS_K), (const bf16_t*)(ws + WS_V), (bf16_t*)(ws + WS_YMIX), (const float*)(ws + WS_KMH)};
              moba::attn_phase((char*)lds_raw, BP, Gp, cp); }
            GRID_BAR();
        }
        PH(8) { PHASE_ENV; pg8::TileOrderT<4> S; S.init(T / 256, 4, Gp, cp);
          pg8::SrcDenseT<FP8_OUT != 0> X{(const char*)(ws + WS_YMIX), (const char*)(ws + WS_WOUT) + (size_t)layer * 1024 * 1024 * (FP8_OUT ? 1 : 2), D, D};
          pg8::EpiOut E{(void*)(ws + WS_Z), (const bf16_t*)(ws + WS_XBF), FP8_OUT ? 1.0f / (32.0f * YMIX_SC) : 1.0f};
          pg8::gemm_phase(ldsp, FP8_OUT ? opaque_s(D) : D, S, X, E); }
        GRID_BAR();
        PH(9) { PHASE_ENV;
          ln1_router_mfma_phase(ldsp, (const bf16_t*)(ws + WS_Z), AIN(1) + (size_t)layer * D, AIN(2) + (size_t)layer * D, AIN(16) + (size_t)layer * D * NE, AIN(17) + (size_t)layer * NE,
                                (float*)(ws + WS_X1BF), (unsigned char*)(ws + WS_X1F8), (float*)(ws + WS_TOKG), GCNT(ws, layer), (int*)(ws + WS_ROWTOK), (int*)(ws + WS_POS), Gp); }
        GRID_BAR();
        const int nconv = (layer + 1 < DEPTH) ? NCONV : 0;
        PH(11) { PHASE_ENV; const int Gg = Gp - opaque_s(nconv);
          if (cp >= Gg) cv_moe_range(ws, ldsp, layer + 1, 0, 32 * 512, Gp - Gg, cp - Gg);
          else { LAS unsigned char* tile_e = ldsp + MISC_TILE_E; const int n_rt = build_tile_e(tile_e, (LAS int*)(ldsp + MISC_TF), GCNT(ws, layer));
          pg8::TileOrderT<8> S; S.init(n_rt, 8, Gg, cp);
          pg8::SrcMoeGather<FP8_GU != 0> X{(const char*)(ws + (FP8_GU ? WS_X1F8 : WS_X1BF)), (const char*)(ws + WS_WGU) + (size_t)layer * NE * 2048 * 1024 * (FP8_GU ? 1 : 2), (const int*)(ws + WS_ROWTOK), tile_e, D, 8, (LAS int*)(ldsp + MISC_TAB), (const LAS int*)(ldsp + MISC_TF)};
          pg8::EpiGU<FP8_GU != 0, FP8_DN != 0> E{(void*)(ws + WS_HBUF), AIN(19) + (size_t)layer * NE * 2048, tile_e, (LAS float*)(ldsp + MISC_BIAS)};
          pg8::gemm_phase(ldsp, opaque_s(D), S, X, E); } }
        GRID_BAR();
        PH(12) { PHASE_ENV; const int Gg = Gp - opaque_s(nconv);
          if (cp >= Gg) cv_moe_range(ws, ldsp, layer + 1, 32 * 512, CV_MOE, Gp - Gg, cp - Gg);
          else { LAS unsigned char* tile_e = ldsp + MISC_TILE_E; const int n_rt = build_tile_e(tile_e, (LAS int*)(ldsp + MISC_TF), GCNT(ws, layer));
          pg8::TileOrderT<4> S; S.init(n_rt, 4, Gg, cp);
          pg8::SrcMoeDense<FP8_DN != 0> X{(const char*)(ws + WS_HBUF), (const char*)(ws + WS_WDN) + (size_t)layer * NE * 1024 * 1024 * (FP8_DN ? 1 : 2), tile_e, D, 4};
          pg8::EpiDown<FP8_DN != 0> E{(void*)(ws + WS_YBUF), AIN(21) + (size_t)layer * NE * D, tile_e, (LAS float*)(ldsp + MISC_BIAS)};
          pg8::gemm_phase(ldsp, opaque_s(D), S, X, E); } }
        GRID_BAR();
        PH(13) { PHASE_ENV;
          if ((layer & 1) == 0) { float* ksz = (float*)(ws + WS_KMH); for (int i = cp * 512 + opaque_tid(); i < 128 * 1024; i += Gp * 512) ksz[i] = 0.f; }
          combine_ln2_phase((const bf16_t*)(ws + WS_X1BF), (const void*)(ws + WS_YBUF), (const int*)(ws + WS_POS), (const float*)(ws + WS_TOKG), AIN(3) + (size_t)layer * D, AIN(4) + (size_t)layer * D,
                            (layer == DEPTH - 1) ? OUTP() : (float*)nullptr, (bf16_t*)(ws + WS_XBF), (unsigned char*)(ws + WS_XF8), Gp, (const bf16_t*)(ws + WS_Z), AIN(1) + (size_t)layer * D, AIN(2) + (size_t)layer * D, ldsp, GCNT(ws, layer)); }
        if (layer != DEPTH - 1) GRID_BAR();
    }
}

extern "C" void kernel_launch(void* const* d_in, const int* in_sizes, int n_in, void* d_out, int out_size, void* d_ws, size_t ws_size, hipStream_t stream) {
    static int grid = 0;
    if (grid == 0) {
        if (n_in != 22 || in_sizes[0] != T * D || out_size != T * D || ws_size < WS_END) { fprintf(stderr, "kernel_launch: unexpected shapes (n_in %d, in0 %d, out %d, ws %zu)\n", n_in, n_in > 0 ? in_sizes[0] : -1, out_size, ws_size); grid = -1; return; }
        int dev = 0, cus = 0, per_cu = 0;
        if (hipGetDevice(&dev) != hipSuccess || hipDeviceGetAttribute(&cus, hipDeviceAttributeMultiprocessorCount, dev) != hipSuccess) { grid = -1; return; }
        if (hipFuncSetAttribute((const void*)fwd_kernel, hipFuncAttributeMaxDynamicSharedMemorySize, LDS_BYTES) != hipSuccess) { fprintf(stderr, "kernel_launch: hipFuncSetAttribute failed\n"); grid = -1; return; }
        if (hipOccupancyMaxActiveBlocksPerMultiprocessor(&per_cu, (const void*)fwd_kernel, 512, LDS_BYTES) != hipSuccess || per_cu < 1) fprintf(stderr, "kernel_launch: occupancy query says %d\n", per_cu);
        (void)hipGetLastError();
        grid = cus;
    }
    if (grid < 0) return;
    if (hipMemsetAsync((char*)d_ws + WS_CTL, 0, CTL_ZERO_BYTES, stream) != hipSuccess) return;
    Args a{};
    for (int i = 0; i < 22; ++i) a.in[i] = (const float*)d_in[i];
    a.out = (float*)d_out; a.ws = (unsigned char*)d_ws;
    hipLaunchKernelGGL(fwd_kernel, dim3(grid), dim3(512), LDS_BYTES, stream, a);
}
```

```cpp
#include <hip/hip_runtime.h>
#include <cstdio>
#include <cstdint>

#define LAS __attribute__((address_space(3)))
#ifndef FP8_X
#define FP8_X 1
#endif
#ifndef FP8_IN
#define FP8_IN 1
#endif
#ifndef FP8_QKV
#define FP8_QKV FP8_X
#endif
#ifndef FP8_OUT
#define FP8_OUT 1
#endif
#define YMIX_SC 8.0f
#ifndef FP8_SCAN
#define FP8_SCAN 1
#endif
#define SCAN_SC 16.0f
#ifndef X1_RECOMPUTE
#define X1_RECOMPUTE (!Z_F32 && FP8_GU)
#endif
#ifndef Z_F32
#define Z_F32 0
#endif
#ifndef Y_F8
#define Y_F8 1
#endif
#ifndef FP8_GU
#define FP8_GU 1
#endif
#ifndef FP8_DN
#define FP8_DN 1
#endif
typedef unsigned short bf16_t;
typedef short bf16x8 __attribute__((ext_vector_type(8)));
typedef short s16x4 __attribute__((ext_vector_type(4)));
typedef float f32x2 __attribute__((ext_vector_type(2)));
typedef float f32x4 __attribute__((ext_vector_type(4)));
typedef float f32x16 __attribute__((ext_vector_type(16)));
typedef unsigned u32x2 __attribute__((ext_vector_type(2)));
typedef unsigned u32x4 __attribute__((ext_vector_type(4)));
typedef int v4i_t __attribute__((ext_vector_type(4)));
typedef int v8i_t __attribute__((ext_vector_type(8)));

constexpr int T = 32768, D = 1024, SEQ = 4096, NE = 32, DEPTH = 4;
constexpr float ALPHA = 1.681792830507429f;
constexpr float LN_EPS = 1e-5f;
constexpr int P_ROWS = 139264;

constexpr size_t MiB = 1u << 20;
constexpr size_t WS_CTL = 0, CTL_ZERO_BYTES = 64 * 1024;
constexpr size_t WS_KMH = 4 * MiB;
constexpr size_t WS_TOKG = 6 * MiB, WS_POS = 7 * MiB, WS_ROWTOK = 8 * MiB;
constexpr size_t WS_WIN = 16 * MiB;
constexpr size_t WS_WGATE = 24 * MiB;
constexpr size_t WS_WOUT = 32 * MiB;
constexpr size_t WS_WQKV = 40 * MiB;
constexpr size_t WS_WGU = 64 * MiB;
constexpr size_t WS_WDN = 576 * MiB;
constexpr size_t WS_XBF = 832 * MiB, WS_X1BF = 896 * MiB;
constexpr size_t WS_Z = 960 * MiB;
constexpr size_t WS_AGG = 1088 * MiB;
constexpr size_t WS_XF8 = 1140 * MiB;
constexpr size_t WS_X1F8 = 1100 * MiB;
constexpr size_t WS_YMIX = 1344 * MiB;
constexpr size_t WS_GG = 1408 * MiB, WS_REC = 1472 * MiB, WS_U = 1536 * MiB, WS_LA = 1600 * MiB, WS_BB = 1728 * MiB;
constexpr size_t WS_Q = 1408 * MiB, WS_K = 1472 * MiB, WS_V = 1536 * MiB;
static_assert(WS_K - WS_Q == 64 * MiB && WS_V - WS_K == 64 * MiB && WS_REC - WS_GG == 64 * MiB, "epilogue strides");
constexpr size_t WS_HBUF = 1856 * MiB, WS_YBUF = 2128 * MiB, WS_END = 2400 * MiB;

constexpr int LDS_SCRATCH = 135168;
constexpr int CV_SCR = 17024;
constexpr int MISC_OFF = 8 * CV_SCR;
constexpr int MISC_HIST = MISC_OFF + 64, MISC_TILE_E = MISC_OFF + 256, MISC_TAB = MISC_OFF + 1280;
constexpr int LDS_BYTES = MISC_OFF + 5120;
constexpr int RT_CAP = 32768;
constexpr int MISC_TF = MISC_OFF + 4352;
constexpr int MISC_BIAS = MISC_TAB + 1024;

#define LDS_WAIT() asm volatile("s_waitcnt lgkmcnt(0)" ::: "memory")
#define VM_WAIT() asm volatile("s_waitcnt vmcnt(0)" ::: "memory")

__device__ __forceinline__ unsigned f2bf(float f) { unsigned u = __float_as_uint(f); return (u + 0x7fffu + ((u >> 16) & 1u)) >> 16; }
__device__ __forceinline__ unsigned pk2(float lo, float hi) { return f2bf(lo) | (f2bf(hi) << 16); }
__device__ __forceinline__ float bflo(unsigned w) { return __uint_as_float(w << 16); }
__device__ __forceinline__ float bfhi(unsigned w) { return __uint_as_float(w & 0xffff0000u); }
__device__ __forceinline__ unsigned cvt_pk_bf16(float lo, float hi) { unsigned r; asm volatile("v_cvt_pk_bf16_f32 %0, %1, %2" : "=v"(r) : "v"(lo), "v"(hi)); return r; }
__device__ __forceinline__ unsigned pk4_fp8(float a, float b, float c, float d) { int w = 0; w = __builtin_amdgcn_cvt_pk_fp8_f32(a, b, w, false); w = __builtin_amdgcn_cvt_pk_fp8_f32(c, d, w, true); return (unsigned)w; }
__device__ __forceinline__ int opaque_tid() { int t = threadIdx.x; asm volatile("" : "+v"(t)); return t; }
template <int CTRL> __device__ __forceinline__ float dppf(float v) { return __uint_as_float(__builtin_amdgcn_update_dpp(0u, __float_as_uint(v), CTRL, 0xf, 0xf, true)); }
__device__ __forceinline__ float wave_sum_fast(float v) {
    v += dppf<0xB1>(v); v += dppf<0x4E>(v); v += dppf<0x141>(v); v += dppf<0x140>(v);
    { auto r = __builtin_amdgcn_permlane16_swap(__float_as_uint(v), __float_as_uint(v), false, false); v = __uint_as_float(r[0]) + __uint_as_float(r[1]); }
    { auto r = __builtin_amdgcn_permlane32_swap(__float_as_uint(v), __float_as_uint(v), false, false); v = __uint_as_float(r[0]) + __uint_as_float(r[1]); }
    return v;
}
__device__ __forceinline__ float wave_max_fast(float v) {
    v = fmaxf(v, dppf<0xB1>(v)); v = fmaxf(v, dppf<0x4E>(v)); v = fmaxf(v, dppf<0x141>(v)); v = fmaxf(v, dppf<0x140>(v));
    { auto r = __builtin_amdgcn_permlane16_swap(__float_as_uint(v), __float_as_uint(v), false, false); v = fmaxf(__uint_as_float(r[0]), __uint_as_float(r[1])); }
    { auto r = __builtin_amdgcn_permlane32_swap(__float_as_uint(v), __float_as_uint(v), false, false); v = fmaxf(__uint_as_float(r[0]), __uint_as_float(r[1])); }
    return v;
}
__device__ __forceinline__ float xr_pair(float a, float b) { auto r = __builtin_amdgcn_permlane32_swap(__float_as_uint(a), __float_as_uint(b), false, false); return __uint_as_float(r[0]) + __uint_as_float(r[1]); }
__device__ __forceinline__ float xreduce16(const float (&t16)[16], int lane) {
    float t8[8], t4[4], t2[2], lv;
#pragma unroll
    for (int j = 0; j < 8; ++j) { auto r = __builtin_amdgcn_permlane16_swap(__float_as_uint(t16[j]), __float_as_uint(t16[8 + j]), false, false); t8[j] = __uint_as_float(r[0]) + __uint_as_float(r[1]); }
    { const bool bt = (lane & 8) != 0;
#pragma unroll
      for (int j = 0; j < 4; ++j) { const float send = bt ? t8[j] : t8[4 + j]; t4[j] = (bt ? t8[4 + j] : t8[j]) + dppf<0x128>(send); } }
    { const bool bt = (lane & 4) != 0;
#pragma unroll
      for (int j = 0; j < 2; ++j) { const float send = bt ? t4[j] : t4[2 + j]; t2[j] = (bt ? t4[2 + j] : t4[j]) + dppf<0x1B>(dppf<0x141>(send)); } }
    { const bool bt = (lane & 2) != 0; const float send = bt ? t2[0] : t2[1]; lv = (bt ? t2[1] : t2[0]) + dppf<0x4E>(send); }
    lv += dppf<0xB1>(lv);
    return lv;
}
__device__ __forceinline__ float wave_sum(float v) {
#pragma unroll
    for (int o = 1; o < 64; o <<= 1) v += __shfl_xor(v, o);
    return v;
}

#define XB_TMO      128
#define XB_XCNT(j)  (256  + 64 * (j))
#define XB_XSUB(j)  (1280 + 64 * (j))
#define XB_XGEN(j)  (2304 + 64 * (j))
#define XB_TOP      3328
#define XB_TOPGEN   3392
#define XCD_BAR_WORDS 3456
#define XB_SPIN_CAP (1u << 21)

__device__ __forceinline__ unsigned xb_ld(unsigned* p)              { return __hip_atomic_load(p, __ATOMIC_RELAXED, __HIP_MEMORY_SCOPE_AGENT); }
__device__ __forceinline__ unsigned xb_add(unsigned* p, unsigned v) { return __hip_atomic_fetch_add(p, v, __ATOMIC_RELAXED, __HIP_MEMORY_SCOPE_AGENT); }
__device__ __forceinline__ unsigned xb_xcc_id() { return (unsigned)__builtin_amdgcn_s_getreg((3 << 11) | 20) & 0xFu; }
#define XB_SPIN(cond, bar) do { unsigned _sp = 0; while (cond) { __builtin_amdgcn_s_sleep(1); \
    if ((++_sp & 255u) == 0u) { if (xb_ld(&(bar)[XB_TMO])) break; if (_sp > XB_SPIN_CAP) { atomicAdd(&(bar)[XB_TMO], 1u); break; } } } } while (0)

struct XcdBarrier { unsigned* bar; unsigned x; volatile LAS unsigned* st; };

__device__ __forceinline__ XcdBarrier xcd_barrier_post(unsigned* bar, volatile LAS unsigned* st) {
    XcdBarrier b; b.bar = bar; b.x = xb_xcc_id(); b.st = st;
    if (threadIdx.x == 0) (void)xb_add(&bar[XB_XCNT(b.x)], 1u);
    return b;
}
__device__ __forceinline__ void xcd_barrier_complete(unsigned* bar, unsigned x, unsigned& nloc, unsigned& nx) {
    const unsigned G = gridDim.x * gridDim.y * gridDim.z;
    unsigned sum, cnt, mine, sp = 0u;
    for (;;) {
        sum = 0u; cnt = 0u; mine = 0u;
#pragma unroll
        for (unsigned j = 0; j < 16; ++j) { const unsigned c = xb_ld(&bar[XB_XCNT(j)]); sum += c; cnt += (c > 0u) ? 1u : 0u; mine = (j == x) ? c : mine; }
        if (sum == G) break;
        __builtin_amdgcn_s_sleep(1);
        if ((++sp & 255u) == 0u) { if (xb_ld(&bar[XB_TMO])) break; if (sp > XB_SPIN_CAP) { atomicAdd(&bar[XB_TMO], 1u); break; } }
    }
    nloc = mine > 0u ? mine : 1u; nx = cnt > 0u ? cnt : 1u;
}
__device__ __forceinline__ void xcd_barrier(const XcdBarrier& b) {
    asm volatile("s_waitcnt vmcnt(0)" ::: "memory");
    __syncthreads();
    if (threadIdx.x == 0) {
        unsigned* bar = b.bar;
        __builtin_amdgcn_s_waitcnt(0);
        unsigned nloc = b.st[0], nx = b.st[1];
        if (nloc == 0u) { xcd_barrier_complete(bar, b.x, nloc, nx); b.st[0] = nloc; b.st[1] = nx; }
        const unsigned old = xb_add(&bar[XB_XSUB(b.x)], 1u);
        const unsigned gen = old / nloc;
        if (old + 1u == (gen + 1u) * nloc) {
            __builtin_amdgcn_fence(__ATOMIC_RELEASE, "agent");
            asm volatile("s_waitcnt vmcnt(0)" ::: "memory");
            const unsigned og = xb_add(&bar[XB_TOP], 1u);
            const unsigned tg = og / nx;
            if (og + 1u == (tg + 1u) * nx) xb_add(&bar[XB_TOPGEN], 1u);
            else XB_SPIN(xb_ld(&bar[XB_TOPGEN]) == tg, bar);
            __builtin_amdgcn_fence(__ATOMIC_ACQUIRE, "agent");
            xb_add(&bar[XB_XGEN(b.x)], 1u);
            asm volatile("s_waitcnt vmcnt(0)" ::: "memory");
        } else {
            XB_SPIN(xb_ld(&bar[XB_XGEN(b.x)]) == gen, bar);
            __builtin_amdgcn_fence(__ATOMIC_ACQUIRE, "agent");
            asm volatile("s_waitcnt vmcnt(0)" ::: "memory");
        }
    }
    __syncthreads();
}

__device__ __forceinline__ const float* arg_ptr(int k);
namespace pg8 {
constexpr int BM = 256, BK = 64, HALF = 128, HTB = HALF * BK * 2, STAGE_BYTES = 8 * HTB, NXCD = 8, WGM = 8;
__host__ __device__ __forceinline__ int lds_byte(int r, int c) { const int st = (r >> 4) * 2 + (c >> 5), rr = r & 15, cc = c & 31, ob = rr * 64 + cc * 2; return st * 1024 + (ob ^ (((ob >> 9) & 1) << 5)); }
__host__ __device__ __forceinline__ void stage_rc(int b, int& R, int& C) { const int st = b / 1024, sb = b % 1024, swz = sb ^ (((sb >> 9) & 1) << 5); R = (st >> 1) * 16 + swz / 64; C = (st & 1) * 32 + (swz % 64) / 2; }
__host__ __device__ __forceinline__ int perm32(int rho) { const int n = rho >> 4, i = rho & 15; return 8 * (i >> 2) + 4 * n + (i & 3); }
struct Unit { int pm, pn; };
template <int NN> struct TileOrderT {
    int nM, nwg, G, c;
    static constexpr int nN = NN;
    __device__ void init(int nM_, int, int G_, int c_) { nM = nM_; nwg = nM * NN; G = G_; c = c_; }
    __device__ bool spare() const { const int rounds = (nwg + G - 1) / G, mine = (nwg - c + G - 1) / G; return mine < rounds; }
    __device__ bool next(int i, Unit& u) const {
        const int L = i * G + c; if (L >= nwg) return false;
        int wgid = L; { const int q = nwg >> 3, r = nwg & 7, xcd = wgid & 7, off = wgid >> 3; wgid = (xcd < r ? xcd * (q + 1) : r * (q + 1) + (xcd - r) * q) + off; }
        constexpr int nig = WGM * NN; const int gid = wgid / nig, fm = gid * WGM, w = wgid - gid * nig, gsz = (nM - fm) < WGM ? (nM - fm) : WGM;
        if (gsz == WGM) { u.pm = fm + (w & (WGM - 1)); u.pn = w >> 3; } else { u.pm = fm + (w % gsz); u.pn = w / gsz; }
        return true;
    }
};
template <bool F8_> struct SrcDenseT {
    static constexpr bool GATHER = false, FP8 = F8_; static constexpr int ES = F8_ ? 1 : 2;
    const char* A; const char* Bt; int lda; int K;
    __device__ __forceinline__ unsigned a_base(const Unit& u) const { return (unsigned)u.pm * 256u * lda * ES; }
    __device__ __forceinline__ void a_offs(const Unit&, const int (&)[2], const int (&)[2], unsigned (&)[2][2]) const {}
    __device__ __forceinline__ void idx_prefetch(const Unit&, int, int) const {}
    __device__ __forceinline__ void a_offs_lds(const int (&)[2], const int (&)[2], unsigned (&)[2][2]) const {}
    __device__ __forceinline__ unsigned b_base(const Unit& u) const { return (unsigned)u.pn * 256u * K * ES; }
};
typedef SrcDenseT<false> SrcDense;
struct SrcGates {
    static constexpr bool GATHER = false, FP8 = false;
    const char* A; const char* Bt; int lda;
    __device__ __forceinline__ unsigned a_base(const Unit& u) const { return ((unsigned)u.pm * 256u * lda + (unsigned)u.pn * 128u) * 2u; }
    __device__ __forceinline__ void a_offs(const Unit&, const int (&)[2], const int (&)[2], unsigned (&)[2][2]) const {}
    __device__ __forceinline__ void idx_prefetch(const Unit&, int, int) const {}
    __device__ __forceinline__ void a_offs_lds(const int (&)[2], const int (&)[2], unsigned (&)[2][2]) const {}
    __device__ __forceinline__ unsigned b_base(const Unit& u) const { return (unsigned)u.pn * 256u * 128u * 2u; }
};
template <bool F8_> struct SrcMoeGather {
    static constexpr bool GATHER = true, FP8 = F8_; static constexpr int ES = F8_ ? 1 : 2;
    const char* A; const char* Bt; const int* row_tok; const LAS unsigned char* tile_e; int lda; int nN; LAS int* idx; const LAS int* tfirst;
    __device__ __forceinline__ int rbase(const Unit& u) const { const int e = __builtin_amdgcn_readfirstlane((int)tile_e[u.pm]); return e * RT_CAP + (u.pm - __builtin_amdgcn_readfirstlane(tfirst[e])) * 256; }
    __device__ __forceinline__ unsigned a_base(const Unit&) const { return 0u; }
    __device__ __forceinline__ void a_offs(const Unit& u, const int (&RA)[2], const int (&CA)[2], unsigned (&ao)[2][2]) const {
        int tk[2][2];
#pragma unroll
        for (int h = 0; h < 2; ++h)
#pragma unroll
            for (int i = 0; i < 2; ++i) tk[h][i] = row_tok[rbase(u) + 128 * h + RA[i]];
#pragma unroll
        for (int h = 0; h < 2; ++h)
#pragma unroll
            for (int i = 0; i < 2; ++i) { ao[h][i] = (unsigned)(tk[h][i] * lda * ES + CA[i] * 2); asm volatile("" : "+v"(ao[h][i])); }
    }
    __device__ __forceinline__ void idx_prefetch(const Unit& u, int wid, int lane) const {
        if (wid < 4) __builtin_amdgcn_global_load_lds((const unsigned*)(row_tok + rbase(u) + wid * 64 + lane), (LAS unsigned*)(idx + wid * 64), 4, 0, 0);
    }
    __device__ __forceinline__ void a_offs_lds(const int (&RA)[2], const int (&CA)[2], unsigned (&ao)[2][2]) const {
#pragma unroll
        for (int h = 0; h < 2; ++h)
#pragma unroll
            for (int i = 0; i < 2; ++i) ao[h][i] = (unsigned)(idx[128 * h + RA[i]] * lda * ES + CA[i] * 2);
    }
    __device__ __forceinline__ unsigned b_base(const Unit& u) const { const int e = __builtin_amdgcn_readfirstlane((int)tile_e[u.pm]); return ((unsigned)e * nN + u.pn) * 256u * lda * ES; }
};
template <bool F8_> struct SrcMoeDense {
    static constexpr bool GATHER = false, FP8 = F8_; static constexpr int ES = F8_ ? 1 : 2;
    const char* A; const char* Bt; const LAS unsigned char* tile_e; int lda; int nN;
    __device__ __forceinline__ unsigned a_base(const Unit& u) const { return (unsigned)u.pm * 256u * lda * ES; }
    __device__ __forceinline__ void a_offs(const Unit&, const int (&)[2], const int (&)[2], unsigned (&)[2][2]) const {}
    __device__ __forceinline__ void idx_prefetch(const Unit&, int, int) const {}
    __device__ __forceinline__ void a_offs_lds(const int (&)[2], const int (&)[2], unsigned (&)[2][2]) const {}
    __device__ __forceinline__ unsigned b_base(const Unit& u) const { const int e = __builtin_amdgcn_readfirstlane((int)tile_e[u.pm]); return ((unsigned)e * nN + u.pn) * 256u * lda * ES; }
};

template <class Epi, class Src, class Ord>
__device__ __forceinline__ void gemm_phase(LAS unsigned char* lds, const int K, const Ord& S, const Src& X, const Epi& E) {
    const int tid = opaque_tid(), wid = __builtin_amdgcn_readfirstlane(tid >> 6), lane = tid & 63, wr = wid >> 2, wc = wid & 3, fr = lane & 15, fq = lane >> 4;
    constexpr bool F8 = Src::FP8; constexpr int ES = F8 ? 1 : 2;
    const int nt = K * ES / (BK * 2);
    constexpr bool GA = Src::GATHER;
    int RA[2], CA[2]; unsigned voffA[2], voffB[2];
#pragma unroll
    for (int i = 0; i < 2; ++i) { int R, C; stage_rc(tid * 16 + i * 8192, R, C); RA[i] = R; CA[i] = C; const int Rb = Epi::PERM ? ((R & ~31) + perm32(R & 31)) : R;
        voffA[i] = (unsigned)(R * X.lda * ES + C * 2); voffB[i] = (unsigned)(Rb * K * ES + C * 2); }
    const unsigned kstep = (unsigned)(BK * 2);
    const unsigned hstep = (unsigned)HALF * K * ES;
    const unsigned hstepA = GA ? 0u : (unsigned)HALF * X.lda * ES;
    const __amdgpu_buffer_rsrc_t rsA = __builtin_amdgcn_make_buffer_rsrc((void*)X.A, 0, 0x7fffffff, 0x00020000), rsB = __builtin_amdgcn_make_buffer_rsrc((void*)X.Bt, 0, 0x7fffffff, 0x00020000);
    const unsigned ldsw = (unsigned)wid * 1024u;
    const int aoff = lds_byte(wr * 64 + fr, fq * 8), boff = lds_byte(wc * 32 + fr, fq * 8);
#define PG8_SA(b, h) (((b) * 2 + (h)) * HTB)
#define PG8_SB(b, h) ((4 + (b) * 2 + (h)) * HTB)
#define PG8_STAGE_R(rs, bufoff, soff, voff) do { _Pragma("unroll") for (int _i = 0; _i < 2; ++_i) \
        __builtin_amdgcn_raw_ptr_buffer_load_lds(rs, (LAS void*)(lds + (bufoff) + ldsw + _i * 8192), 16, (int)(voff)[_i], (int)(soff), 0, 0); } while (0)
#define PG8_STAGE(bufoff, soff, voff) PG8_STAGE_R(rsB, bufoff, soff, voff)
#define PG8_STAGE_A(bufoff, soff, h, g0, g1) do { if constexpr (GA) { unsigned _o[2] = {g0, g1}; PG8_STAGE_R(rsA, bufoff, soff, _o); } else { PG8_STAGE_R(rsA, bufoff, (soff) + ((h) ? hstepA : 0u), voffA); } } while (0)
#define PG8_LDA(dst, b, h) do { _Pragma("unroll") for (int m = 0; m < 4; ++m) _Pragma("unroll") for (int k = 0; k < 2; ++k) dst[m][k] = *(const LAS bf16x8*)(lds + PG8_SA(b, h) + aoff + m * 2048 + k * 1024); } while (0)
#define PG8_LDB(dst, b, h) do { _Pragma("unroll") for (int n = 0; n < 2; ++n) _Pragma("unroll") for (int k = 0; k < 2; ++k) dst[n][k] = *(const LAS bf16x8*)(lds + PG8_SB(b, h) + boff + n * 2048 + k * 1024); } while (0)
#define PG8_CAT(x0, x1) __builtin_shufflevector(__builtin_bit_cast(v4i_t, x0), __builtin_bit_cast(v4i_t, x1), 0, 1, 2, 3, 4, 5, 6, 7)
#define PG8_MMA(ai, bj, At, Bt) do { __builtin_amdgcn_s_setprio(1); \
        if constexpr (F8) { _Pragma("unroll") for (int n = 0; n < 2; ++n) { const v8i_t b8_ = PG8_CAT(Bt[n][0], Bt[n][1]); _Pragma("unroll") for (int m = 0; m < 4; ++m) { const v8i_t a8_ = PG8_CAT(At[m][0], At[m][1]); \
            asm volatile("v_mfma_f32_16x16x128_f8f6f4 %0, %1, %2, %0" : "+v"(acc[ai][bj][m][n]) : "v"(b8_), "v"(a8_)); } } }     \
        else { _Pragma("unroll") for (int m = 0; m < 4; ++m) _Pragma("unroll") for (int n = 0; n < 2; ++n) _Pragma("unroll") for (int k = 0; k < 2; ++k) \
            acc[ai][bj][m][n] = __builtin_amdgcn_mfma_f32_16x16x32_bf16(Bt[n][k], At[m][k], acc[ai][bj][m][n], 0, 0, 0); } \
        __builtin_amdgcn_s_setprio(0); } while (0)
#define PG8_MMA_Z(ai, bj, At, Bt) do { if constexpr (F8 && Epi::ZC) { if (t == 0) { __builtin_amdgcn_s_setprio(1); \
            _Pragma("unroll") for (int n = 0; n < 2; ++n) { const v8i_t b8_ = PG8_CAT(Bt[n][0], Bt[n][1]); _Pragma("unroll") for (int m = 0; m < 4; ++m) { const v8i_t a8_ = PG8_CAT(At[m][0], At[m][1]); \
                asm volatile("v_mfma_f32_16x16x128_f8f6f4 %0, %1, %2, 0" : "+v"(acc[ai][bj][m][n]) : "v"(b8_), "v"(a8_)); } }     \
            __builtin_amdgcn_s_setprio(0); } else PG8_MMA(ai, bj, At, Bt); } else PG8_MMA(ai, bj, At, Bt); } while (0)
#define PG8_WAIT_V(n) asm volatile("s_waitcnt vmcnt(" #n ")" ::: "memory")
#define PG8_WAIT_L(n) asm volatile("s_waitcnt lgkmcnt(" #n ")" ::: "memory")
#define PG8_BAR __builtin_amdgcn_s_barrier()
#define PG8_SCHED __builtin_amdgcn_sched_barrier(0)
    Unit cur, nxt; int ui = 0;
    if (!S.next(0, cur)) return;
    f32x4 acc[2][2][4][2];
    if constexpr (!(F8 && Epi::ZC)) {
#pragma unroll
    for (int a = 0; a < 2; ++a)
#pragma unroll
        for (int b = 0; b < 2; ++b)
#pragma unroll
            for (int m = 0; m < 4; ++m)
#pragma unroll
                for (int n = 0; n < 2; ++n) acc[a][b][m][n] = (f32x4){0.f, 0.f, 0.f, 0.f}; }
    bf16x8 At[4][2], B0[2][2], B1[2][2];
    unsigned ao[2][2] = {{0u, 0u}, {0u, 0u}}, nao[2][2] = {{0u, 0u}, {0u, 0u}};
    unsigned cA = X.a_base(cur); if constexpr (GA) X.a_offs(cur, RA, CA, ao);
    unsigned cB = X.b_base(cur);
    PG8_STAGE(PG8_SB(0, 0), cB, voffB); PG8_STAGE_A(PG8_SA(0, 0), cA, 0, ao[0][0], ao[0][1]); PG8_STAGE(PG8_SB(0, 1), cB + hstep, voffB); PG8_STAGE_A(PG8_SA(0, 1), cA, 1, ao[1][0], ao[1][1]);
    if (wr == 1) PG8_BAR;
    PG8_WAIT_V(4); PG8_BAR;
    PG8_STAGE(PG8_SB(1, 0), cB + kstep, voffB); PG8_STAGE_A(PG8_SA(1, 0), cA + kstep, 0, ao[0][0], ao[0][1]); PG8_STAGE(PG8_SB(1, 1), cB + hstep + kstep, voffB);
    PG8_WAIT_V(6); PG8_BAR;
    for (;;) {
        const bool has_next = S.next(ui + 1, nxt);
        E.prefetch(cur, ui, wid, lane);
        unsigned nA = cA, nB = cB;
        if constexpr (GA) {
#pragma unroll
            for (int h = 0; h < 2; ++h)
#pragma unroll
                for (int i = 0; i < 2; ++i) nao[h][i] = ao[h][i]; }
        if (has_next) { nA = X.a_base(nxt); nB = X.b_base(nxt); if constexpr (GA) X.idx_prefetch(nxt, wid, lane); }
        for (int t = 0; t < nt; t += 2) {
            const bool last = (t == nt - 2);
            if constexpr (GA) { if (last && has_next) X.a_offs_lds(RA, CA, nao); }
            const unsigned a1 = cA + (unsigned)(t + 1) * kstep;
            const unsigned a2 = last ? nA : cA + (unsigned)(t + 2) * kstep, b2 = last ? nB : cB + (unsigned)(t + 2) * kstep;
            const unsigned a3 = a2 + kstep, b3 = b2 + kstep;
            unsigned s00 = 0u, s01 = 0u, s10 = 0u, s11 = 0u;
            if constexpr (GA) { s00 = last ? nao[0][0] : ao[0][0]; s01 = last ? nao[0][1] : ao[0][1]; s10 = last ? nao[1][0] : ao[1][0]; s11 = last ? nao[1][1] : ao[1][1]; }
            PG8_LDB(B0, 0, 0); PG8_SCHED; PG8_LDA(At, 0, 0); PG8_STAGE_A(PG8_SA(1, 1), a1, 1, ao[1][0], ao[1][1]);
            PG8_WAIT_L(8); PG8_BAR; PG8_WAIT_L(0); PG8_MMA_Z(0, 0, At, B0); PG8_BAR; PG8_SCHED;
            PG8_LDB(B1, 0, 1); PG8_STAGE(PG8_SB(0, 0), b2, voffB);
            PG8_BAR; PG8_WAIT_L(0); PG8_MMA_Z(0, 1, At, B1); PG8_BAR;
            PG8_LDA(At, 0, 1); PG8_STAGE_A(PG8_SA(0, 0), a2, 0, s00, s01);
            PG8_BAR; PG8_WAIT_L(0); PG8_MMA_Z(1, 0, At, B0); PG8_BAR; PG8_SCHED;
            PG8_STAGE(PG8_SB(0, 1), b2 + hstep, voffB);
            PG8_WAIT_V(6); PG8_BAR; PG8_MMA_Z(1, 1, At, B1); PG8_BAR;
            PG8_LDB(B0, 1, 0); PG8_SCHED; PG8_LDA(At, 1, 0); PG8_STAGE_A(PG8_SA(0, 1), a2, 1, s10, s11);
            PG8_WAIT_L(8); PG8_BAR; PG8_WAIT_L(0); PG8_MMA(0, 0, At, B0); PG8_BAR; PG8_SCHED;
            PG8_LDB(B1, 1, 1); PG8_STAGE(PG8_SB(1, 0), b3, voffB);
            PG8_BAR; PG8_WAIT_L(0); PG8_MMA(0, 1, At, B1); PG8_BAR;
            PG8_LDA(At, 1, 1); PG8_STAGE_A(PG8_SA(1, 0), a3, 0, s00, s01);
            PG8_BAR; PG8_WAIT_L(0); PG8_MMA(1, 0, At, B0); PG8_BAR; PG8_SCHED;
            PG8_STAGE(PG8_SB(1, 1), b3 + hstep, voffB);
            PG8_WAIT_V(6); PG8_BAR; PG8_MMA(1, 1, At, B1); PG8_BAR;
        }
        { const int tz = opaque_tid(); const int wz = __builtin_amdgcn_readfirstlane(tz >> 6), lz = tz & 63;
          E(acc, cur, wz >> 2, wz & 3, lz & 15, lz >> 4, ui); }
        if (!has_next) break;
        if constexpr (!(F8 && Epi::ZC))
#pragma unroll
        for (int a = 0; a < 2; ++a)
#pragma unroll
            for (int b = 0; b < 2; ++b)
#pragma unroll
                for (int m = 0; m < 4; ++m)
#pragma unroll
                    for (int n = 0; n < 2; ++n) acc[a][b][m][n] = (f32x4){0.f, 0.f, 0.f, 0.f};
        cur = nxt; cA = nA; cB = nB; ++ui;
        if constexpr (GA) {
#pragma unroll
            for (int h = 0; h < 2; ++h)
#pragma unroll
                for (int i = 0; i < 2; ++i) ao[h][i] = nao[h][i]; }
    }
    PG8_WAIT_V(0);
    if (wr == 0) PG8_BAR;
    PG8_BAR;
#undef PG8_SA
#undef PG8_SB
#undef PG8_STAGE
#undef PG8_STAGE_R
#undef PG8_STAGE_A
#undef PG8_LDA
#undef PG8_LDB
#undef PG8_MMA
#undef PG8_CAT
#undef PG8_WAIT_V
#undef PG8_WAIT_L
#undef PG8_BAR
#undef PG8_SCHED
}

__device__ __forceinline__ float sigmoidf_(float x) { return __builtin_amdgcn_rcpf(1.0f + __expf(-x)); }
__device__ __forceinline__ f32x4 gelu_tanh4(f32x4 x) {
    f32x4 t = x * (x * x * 0.044715f + 1.0f) * (-2.0f * 0.7978845608028654f * 1.4426950408889634f);
    t[0] = __builtin_amdgcn_exp2f(t[0]); t[1] = __builtin_amdgcn_exp2f(t[1]); t[2] = __builtin_amdgcn_exp2f(t[2]); t[3] = __builtin_amdgcn_exp2f(t[3]);
    t = t + 1.0f;
    t[0] = __builtin_amdgcn_rcpf(t[0]); t[1] = __builtin_amdgcn_rcpf(t[1]); t[2] = __builtin_amdgcn_rcpf(t[2]); t[3] = __builtin_amdgcn_rcpf(t[3]);
    return x * t;
}
__device__ __forceinline__ float gelu_tanh(float x) { const float t = 0.7978845608028654f * (x + 0.044715f * x * x * x); return x * __builtin_amdgcn_rcpf(1.0f + __expf(-2.0f * t)); }

struct EpiIn {
    static constexpr bool PERM = true, ZC = true;
    bf16_t* gg; float asc;
    __device__ __forceinline__ void prefetch(const Unit&, int, int, int) const {}
    __device__ __forceinline__ void operator()(const f32x4 (&acc)[2][2][4][2], const Unit& u, int wr, int wc, int fr, int fq, int) const {
        const bool is_gate = u.pn < 4;
        bf16_t* base = gg + (is_gate ? (size_t)0 : (size_t)(32u << 20));
        const int row0 = u.pm * BM + wr * 64 + fr, col0 = (u.pn & 3) * BM + wc * 32 + 8 * fq;
#pragma unroll
        for (int ai = 0; ai < 2; ++ai)
#pragma unroll
            for (int m = 0; m < 4; ++m) { bf16_t* rowp = base + (size_t)(row0 + ai * HALF + m * 16) * D + col0;
#pragma unroll
                for (int bj = 0; bj < 2; ++bj) { f32x4 v0 = acc[ai][bj][m][0] * asc, v1 = acc[ai][bj][m][1] * asc;
                    if (is_gate) { v0 = gelu_tanh4(v0); v1 = gelu_tanh4(v1); }
                    if (FP8_SCAN && is_gate) { v0 = v0 * SCAN_SC; v1 = v1 * SCAN_SC; u32x2 w; w.x = pk4_fp8(v0[0], v0[1], v0[2], v0[3]); w.y = pk4_fp8(v1[0], v1[1], v1[2], v1[3]);
                        *(u32x2*)((unsigned char*)gg + (size_t)(row0 + ai * HALF + m * 16) * D + col0 + bj * HALF) = w; }
                    else { u32x4 w; w.x = cvt_pk_bf16(v0[0], v0[1]); w.y = cvt_pk_bf16(v0[2], v0[3]); w.z = cvt_pk_bf16(v1[0], v1[1]); w.w = cvt_pk_bf16(v1[2], v1[3]);
                    *(u32x4*)(rowp + bj * HALF) = w; } } }
    }
};
struct EpiQKV {
    static constexpr bool PERM = true, ZC = false;
    static constexpr float asc = FP8_QKV ? (1.0f / 32.0f) : 1.0f;
    __device__ __forceinline__ void prefetch(const Unit&, int, int, int) const {}
    __device__ __forceinline__ void operator()(const f32x4 (&acc)[2][2][4][2], const Unit& u, int wr, int wc, int fr, int fq, int) const {
        const int which = u.pn >> 2;
        unsigned char* wsb = (unsigned char*)arg_ptr(23);
        bf16_t* base = (bf16_t*)(wsb + WS_Q) + (size_t)which * (size_t)(32u << 20);
        float* ksum = (float*)(wsb + WS_KMH);
        const int row0 = u.pm * BM + wr * 64 + fr, col0 = (u.pn & 3) * BM + wc * 32 + 8 * fq;
        f32x4 ks[2][2] = {};
        float crev[4];
#pragma unroll
        for (int j = 0; j < 4; ++j) crev[j] = __builtin_amdgcn_exp2f(-(float)(16 * wc + 4 * fq + j) * (13.287712379549449f / 64.0f)) * 0.15915494309189535f;
#pragma unroll
        for (int ai = 0; ai < 2; ++ai)
#pragma unroll
            for (int m = 0; m < 4; ++m) { const int row = row0 + ai * HALF + m * 16; bf16_t* rowp = base + (size_t)row * D + col0;
                float c0 = 1.f, c1 = 1.f, c2 = 1.f, c3 = 1.f, s0 = 0.f, s1 = 0.f, s2 = 0.f, s3 = 0.f;
                if (which < 2) { const float sp = (float)(row & (SEQ - 1));
                    const float x0 = __builtin_amdgcn_fractf(sp * crev[0]), x1 = __builtin_amdgcn_fractf(sp * crev[1]), x2 = __builtin_amdgcn_fractf(sp * crev[2]), x3 = __builtin_amdgcn_fractf(sp * crev[3]);
                    c0 = __builtin_amdgcn_cosf(x0); c1 = __builtin_amdgcn_cosf(x1); c2 = __builtin_amdgcn_cosf(x2); c3 = __builtin_amdgcn_cosf(x3);
                    s0 = __builtin_amdgcn_sinf(x0); s1 = __builtin_amdgcn_sinf(x1); s2 = __builtin_amdgcn_sinf(x2); s3 = __builtin_amdgcn_sinf(x3); }
                const f32x4 cs = (f32x4){c0, c1, c2, c3}, sn = (f32x4){s0, s1, s2, s3};
#pragma unroll
                for (int bj = 0; bj < 2; ++bj) { const f32x4 t1 = acc[ai][bj][m][0] * asc, t2 = acc[ai][bj][m][1] * asc;
                    const f32x4 o1 = t1 * cs - t2 * sn, o2 = t2 * cs + t1 * sn;
                    ks[bj][0] += o1; ks[bj][1] += o2;
                    u32x4 w; w.x = cvt_pk_bf16(o1[0], o1[1]); w.y = cvt_pk_bf16(o1[2], o1[3]); w.z = cvt_pk_bf16(o2[0], o2[1]); w.w = cvt_pk_bf16(o2[2], o2[3]);
                    *(u32x4*)(rowp + bj * HALF) = w; } }
        if (which == 1) {
            float* kp = ksum + (size_t)u.pm * D + col0;
#pragma unroll
            for (int bj = 0; bj < 2; ++bj)
#pragma unroll
                for (int h2 = 0; h2 < 2; ++h2)
#pragma unroll
                    for (int e = 0; e < 4; ++e) { float v = ks[bj][h2][e];
                        v += dppf<0xB1>(v); v += dppf<0x4E>(v); v += dppf<0x141>(v); v += dppf<0x140>(v);
                        if (fr == 0) __hip_atomic_fetch_add(kp + bj * HALF + 4 * h2 + e, v, __ATOMIC_RELAXED, __HIP_MEMORY_SCOPE_AGENT); } }
    }
};
struct EpiOut {
    static constexpr bool PERM = true, ZC = true;
    void* z; const bf16_t* xres; float asc;
    __device__ __forceinline__ void prefetch(const Unit&, int, int, int) const {}
    __device__ __forceinline__ void operator()(const f32x4 (&acc)[2][2][4][2], const Unit& u, int wr, int wc, int fr, int fq, int) const {
        const int row0 = u.pm * BM + wr * 64 + fr, col0 = u.pn * BM + wc * 32 + 8 * fq;
        u32x4 xw[2][4][2];
#pragma unroll
        for (int ai = 0; ai < 2; ++ai)
#pragma unroll
            for (int m = 0; m < 4; ++m)
#pragma unroll
                for (int bj = 0; bj < 2; ++bj) xw[ai][m][bj] = *(const u32x4*)(xres + (size_t)(row0 + ai * HALF + m * 16) * D + col0 + bj * HALF);
#pragma unroll
        for (int ai = 0; ai < 2; ++ai)
#pragma unroll
            for (int m = 0; m < 4; ++m) { const size_t off = (size_t)(row0 + ai * HALF + m * 16) * D + col0;
#pragma unroll
                for (int bj = 0; bj < 2; ++bj) { const u32x4 w4 = xw[ai][m][bj];
                    const f32x4 x0 = (f32x4){bflo(w4.x), bfhi(w4.x), bflo(w4.y), bfhi(w4.y)}, x1 = (f32x4){bflo(w4.z), bfhi(w4.z), bflo(w4.w), bfhi(w4.w)};
                    const f32x4 v0 = FP8_OUT ? acc[ai][bj][m][0] * asc + x0 * ALPHA : acc[ai][bj][m][0] + x0 * ALPHA, v1 = FP8_OUT ? acc[ai][bj][m][1] * asc + x1 * ALPHA : acc[ai][bj][m][1] + x1 * ALPHA;
                    if (Z_F32) { *(f32x4*)((float*)z + off + bj * HALF) = v0; *(f32x4*)((float*)z + off + bj * HALF + 4) = v1; }
                    else { u32x4 w; w.x = cvt_pk_bf16(v0[0], v0[1]); w.y = cvt_pk_bf16(v0[2], v0[3]); w.z = cvt_pk_bf16(v1[0], v1[1]); w.w = cvt_pk_bf16(v1[2], v1[3]);
                    *(u32x4*)((bf16_t*)z + off + bj * HALF) = w; } } }
    }
};
struct EpiGates {
    static constexpr bool PERM = true, ZC = true;
    bf16_t* la; bf16_t* bb; const bf16_t* ub; const float* bga; const float* bgx; const float* lam;
    __device__ __forceinline__ void prefetch(const Unit&, int, int, int) const {}
    __device__ __forceinline__ void operator()(const f32x4 (&acc)[2][2][4][2], const Unit& u, int wr, int wc, int fr, int fq, int) const {
        const int row0 = u.pm * BM + wr * 64 + fr, ch0 = u.pn * HALF + wc * 32 + 8 * fq;
        f32x4 ba[2], bx[2], ls[2];
#pragma unroll
        for (int n = 0; n < 2; ++n) { ba[n] = *(const f32x4*)(bga + ch0 + n * 4); bx[n] = *(const f32x4*)(bgx + ch0 + n * 4); const f32x4 l = *(const f32x4*)(lam + ch0 + n * 4);
#pragma unroll
            for (int j = 0; j < 4; ++j) ls[n][j] = -8.0f * log1pf(__expf(-l[j])); }
        u32x4 uws[2][4];
#pragma unroll
        for (int ai = 0; ai < 2; ++ai)
#pragma unroll
            for (int m = 0; m < 4; ++m) uws[ai][m] = *(const u32x4*)(ub + (size_t)(row0 + ai * HALF + m * 16) * D + ch0);
#pragma unroll
        for (int ai = 0; ai < 2; ++ai)
#pragma unroll
            for (int m = 0; m < 4; ++m) { const int row = row0 + ai * HALF + m * 16; const size_t off = (size_t)row * D + ch0; const bool first = (row & (SEQ - 1)) == 0;
                const u32x4 uw = uws[ai][m];
                const float uv[2][4] = {{bflo(uw.x), bfhi(uw.x), bflo(uw.y), bfhi(uw.y)}, {bflo(uw.z), bfhi(uw.z), bflo(uw.w), bfhi(uw.w)}};
                f32x4 lo[2], bo[2];
#pragma unroll
                for (int n = 0; n < 2; ++n)
#pragma unroll
                    for (int j = 0; j < 4; j += 2) {
                        f32x2 ea = ((f32x2){acc[ai][0][m][n][j], acc[ai][0][m][n][j + 1]} + (f32x2){ba[n][j], ba[n][j + 1]}) * -1.4426950408889634f;
                        f32x2 ex = ((f32x2){acc[ai][1][m][n][j], acc[ai][1][m][n][j + 1]} + (f32x2){bx[n][j], bx[n][j + 1]}) * -1.4426950408889634f;
                        ea[0] = __builtin_amdgcn_exp2f(ea[0]); ea[1] = __builtin_amdgcn_exp2f(ea[1]); ex[0] = __builtin_amdgcn_exp2f(ex[0]); ex[1] = __builtin_amdgcn_exp2f(ex[1]);
                        ea = ea + 1.0f; ex = ex + 1.0f;
                        f32x2 sa, sx; sa[0] = __builtin_amdgcn_rcpf(ea[0]); sa[1] = __builtin_amdgcn_rcpf(ea[1]); sx[0] = __builtin_amdgcn_rcpf(ex[0]); sx[1] = __builtin_amdgcn_rcpf(ex[1]);
                        const f32x2 l2 = sa * (f32x2){ls[n][j], ls[n][j + 1]}; const f32x2 t2 = l2 * -2.0f;
                        const f32x2 ser = t2 * (t2 * -0.5f + 1.0f); f32x2 dx = t2 * -1.4426950408889634f; dx[0] = __builtin_amdgcn_exp2f(dx[0]); dx[1] = __builtin_amdgcn_exp2f(dx[1]); dx = 1.0f - dx;
                        f32x2 mult; mult[0] = first ? 1.0f : __builtin_amdgcn_sqrtf(t2[0] < 1e-3f ? ser[0] : dx[0]); mult[1] = first ? 1.0f : __builtin_amdgcn_sqrtf(t2[1] < 1e-3f ? ser[1] : dx[1]);
                        const f32x2 b2 = mult * sx * (f32x2){uv[n][j], uv[n][j + 1]};
                        lo[n][j] = l2[0]; lo[n][j + 1] = l2[1]; bo[n][j] = b2[0]; bo[n][j + 1] = b2[1]; }
                u32x4 w; w.x = cvt_pk_bf16(lo[0][0], lo[0][1]); w.y = cvt_pk_bf16(lo[0][2], lo[0][3]); w.z = cvt_pk_bf16(lo[1][0], lo[1][1]); w.w = cvt_pk_bf16(lo[1][2], lo[1][3]);
                *(u32x4*)(la + off) = w;
                if (FP8_SCAN) { const f32x4 s0 = bo[0] * SCAN_SC, s1 = bo[1] * SCAN_SC; u32x2 w8; w8.x = pk4_fp8(s0[0], s0[1], s0[2], s0[3]); w8.y = pk4_fp8(s1[0], s1[1], s1[2], s1[3]); *(u32x2*)((unsigned char*)bb + off) = w8; }
                else { w.x = cvt_pk_bf16(bo[0][0], bo[0][1]); w.y = cvt_pk_bf16(bo[0][2], bo[0][3]); w.z = cvt_pk_bf16(bo[1][0], bo[1][1]); w.w = cvt_pk_bf16(bo[1][2], bo[1][3]);
                *(u32x4*)(bb + off) = w; } }
    }
};
template <bool IN8, bool OUT8> struct EpiGU {
    static constexpr bool PERM = true, ZC = true;
    void* hb; const float* bgu; const LAS unsigned char* tile_e; LAS float* bl;
    __device__ __forceinline__ void prefetch(const Unit& u, int ui, int wid, int lane) const {
        if (wid < 4) { const int e = __builtin_amdgcn_readfirstlane((int)tile_e[u.pm]);
            const float* src = bgu + (size_t)e * 2048 + (wid >> 1) * 1024 + u.pn * HALF + (wid & 1) * 64 + lane;
            __builtin_amdgcn_global_load_lds((const unsigned*)src, (LAS unsigned*)(bl + (ui & 1) * 256 + wid * 64), 4, 0, 0); }
    }
    __device__ __forceinline__ void operator()(const f32x4 (&acc)[2][2][4][2], const Unit& u, int wr, int wc, int fr, int fq, int ui) const {
        const int row0 = u.pm * BM + wr * 64 + fr, col0 = u.pn * HALF + wc * 32 + 8 * fq;
        const LAS float* bp = bl + (ui & 1) * 256 + wc * 32 + 8 * fq;
        const f32x4 bg0 = *(const LAS f32x4*)(bp), bg1 = *(const LAS f32x4*)(bp + 4), bu0 = *(const LAS f32x4*)(bp + 128) + 1.0f, bu1 = *(const LAS f32x4*)(bp + 132) + 1.0f;
#pragma unroll
        for (int ai = 0; ai < 2; ++ai)
#pragma unroll
            for (int m = 0; m < 4; ++m) { const size_t eoff = (size_t)(row0 + ai * HALF + m * 16) * D + col0; constexpr float asc = IN8 ? (1.0f / 32.0f) : 1.0f;
                f32x4 h0, h1;
#define GU_PAIR(HO, N_, BG, BU, J0) do { f32x2 g2 = __builtin_elementwise_fma((f32x2){acc[ai][0][m][N_][J0], acc[ai][0][m][N_][J0 + 1]}, (f32x2){asc, asc}, (f32x2){BG[J0], BG[J0 + 1]});     \
                    f32x2 u2 = __builtin_elementwise_fma((f32x2){acc[ai][1][m][N_][J0], acc[ai][1][m][N_][J0 + 1]}, (f32x2){asc, asc}, (f32x2){BU[J0], BU[J0 + 1]});                                                     \
                    g2[0] = fminf(g2[0], 7.0f); g2[1] = fminf(g2[1], 7.0f); u2[0] = __builtin_amdgcn_fmed3f(u2[0], -6.0f, 8.0f); u2[1] = __builtin_amdgcn_fmed3f(u2[1], -6.0f, 8.0f);     \
                    f32x2 e2 = g2 * -2.45546696f; e2[0] = __builtin_amdgcn_exp2f(e2[0]); e2[1] = __builtin_amdgcn_exp2f(e2[1]); e2 = e2 + 1.0f;                             \
                    f32x2 r2; r2[0] = __builtin_amdgcn_rcpf(e2[0]); r2[1] = __builtin_amdgcn_rcpf(e2[1]);                                                                     \
                    const f32x2 hh = u2 * (g2 * r2); HO[J0] = hh[0]; HO[J0 + 1] = hh[1]; } while (0)
                GU_PAIR(h0, 0, bg0, bu0, 0); GU_PAIR(h0, 0, bg0, bu0, 2); GU_PAIR(h1, 1, bg1, bu1, 0); GU_PAIR(h1, 1, bg1, bu1, 2);
#undef GU_PAIR
                if constexpr (OUT8) { u32x2 w; w.x = pk4_fp8(h0[0], h0[1], h0[2], h0[3]); w.y = pk4_fp8(h1[0], h1[1], h1[2], h1[3]); *(u32x2*)((unsigned char*)hb + eoff) = w; }
                else { u32x4 w; w.x = cvt_pk_bf16(h0[0], h0[1]); w.y = cvt_pk_bf16(h0[2], h0[3]); w.z = cvt_pk_bf16(h1[0], h1[1]); w.w = cvt_pk_bf16(h1[2], h1[3]); *(u32x4*)((bf16_t*)hb + eoff) = w; } }
    }
};
template <bool IN8> struct EpiDown {
    static constexpr bool PERM = true, ZC = true;
    void* yb; const float* bdn; const LAS unsigned char* tile_e; LAS float* bl;
    __device__ __forceinline__ void prefetch(const Unit& u, int ui, int wid, int lane) const {
        if (wid < 4) { const int e = __builtin_amdgcn_readfirstlane((int)tile_e[u.pm]);
            __builtin_amdgcn_global_load_lds((const unsigned*)(bdn + (size_t)e * D + u.pn * BM + wid * 64 + lane), (LAS unsigned*)(bl + (ui & 1) * 256 + wid * 64), 4, 0, 0); }
    }
    __device__ __forceinline__ void operator()(const f32x4 (&acc)[2][2][4][2], const Unit& u, int wr, int wc, int fr, int fq, int ui) const {
        const int row0 = u.pm * BM + wr * 64 + fr, col0 = u.pn * BM + wc * 32 + 8 * fq;
        f32x4 bv[2][2];
#pragma unroll
        for (int bj = 0; bj < 2; ++bj)
#pragma unroll
            for (int n = 0; n < 2; ++n) bv[bj][n] = *(const LAS f32x4*)(bl + (ui & 1) * 256 + bj * HALF + wc * 32 + 8 * fq + 4 * n) * (Y_F8 ? 16.0f : 1.0f);
#pragma unroll
        for (int ai = 0; ai < 2; ++ai)
#pragma unroll
            for (int m = 0; m < 4; ++m) { const size_t eoff = (size_t)(row0 + ai * HALF + m * 16) * D + col0;
#pragma unroll
                for (int bj = 0; bj < 2; ++bj) { constexpr float asc = (IN8 ? (1.0f / 64.0f) : 1.0f) * (Y_F8 ? 16.0f : 1.0f); const f32x4 v0 = __builtin_elementwise_fma(acc[ai][bj][m][0], (f32x4){asc, asc, asc, asc}, bv[bj][0]), v1 = __builtin_elementwise_fma(acc[ai][bj][m][1], (f32x4){asc, asc, asc, asc}, bv[bj][1]);
                    if (Y_F8) { const f32x4 s0 = v0, s1 = v1; u32x2 w; w.x = pk4_fp8(s0[0], s0[1], s0[2], s0[3]); w.y = pk4_fp8(s1[0], s1[1], s1[2], s1[3]); *(u32x2*)((unsigned char*)yb + eoff + bj * HALF) = w; }
                    else { u32x4 w; w.x = cvt_pk_bf16(v0[0], v0[1]); w.y = cvt_pk_bf16(v0[2], v0[3]); w.z = cvt_pk_bf16(v1[0], v1[1]); w.w = cvt_pk_bf16(v1[2], v1[3]);
                    *(u32x4*)((bf16_t*)yb + eoff + bj * HALF) = w; } } }
    }
};
}

namespace moba {
constexpr int HD = 128, LD = 1024;
constexpr float SCALE = 0.08838834764831845f;
constexpr float THR = 8.f;
constexpr int NW = 8, QBLK = 32, KVBLK = 64, QB = NW * QBLK;
constexpr int SHM_V = KVBLK * HD * 2, SHM_K = KVBLK * HD * 2;
constexpr int G_OFF = 2 * SHM_V + 2 * SHM_K + NW * 64 * 4;
constexpr int LDS_ATT = G_OFF + 8192;

#define KSWZ(row, colB) ((row) * 256 + ((colB) ^ (((row) & 7) << 4)))
#define SBAR() __builtin_amdgcn_sched_barrier(0)
__device__ __forceinline__ int v_st(int k, int c) { const int kk = (k & ~0xC) | ((k & 4) << 1) | ((k & 8) >> 1); return ((kk >> 3) * 4 + (c >> 5)) * 512 + ((kk & 7) * 32 + (c & 31)) * 2; }
__device__ __forceinline__ int v_rd_base(int lane) { return ((lane & 3) << 3) | (((lane >> 2) & 3) << 6) | (((lane >> 4) & 1) << 5) | (((lane >> 5) & 1) << 8); }
constexpr int v_rd_off(int d0, int ks, int half) { return d0 * 512 + ks * 4096 + half * 2048; }
__device__ __forceinline__ int crow(int r, int hi) { return (r & 3) + 8 * (r >> 2) + 4 * hi; }
__device__ __forceinline__ unsigned cvtpk(float lo, float hi) { unsigned r; asm volatile("v_cvt_pk_bf16_f32 %0, %1, %2" : "=v"(r) : "v"(lo), "v"(hi)); return r; }
__device__ __forceinline__ bf16x8 load8(const bf16_t* p) { return *reinterpret_cast<const bf16x8*>(p); }
__device__ __forceinline__ void mask_tile(f32x16& p0, f32x16& p1, int dq) {
    const float NEG = -__builtin_inff();
#pragma unroll
    for (int r = 0; r < 16; ++r) {
        const int c = (r & 3) + 8 * (r >> 2);
        if (dq - c < 0) p0[r] = NEG;
        if (dq - c - 32 < 0) p1[r] = NEG;
    }
}
__device__ __forceinline__ void partialSM(f32x16& p0, f32x16& p1, float& m_reg, float& mn, float& alpha, bool keep = true) {
    float pmax = p0[0];
#pragma unroll
    for (int r = 1; r < 16; ++r) pmax = fmaxf(pmax, p0[r]);
#pragma unroll
    for (int r = 0; r < 16; ++r) pmax = fmaxf(pmax, p1[r]);
    { auto rr = __builtin_amdgcn_permlane32_swap(__float_as_uint(pmax), __float_as_uint(pmax), false, false);
      pmax = fmaxf(__uint_as_float(rr[0]), __uint_as_float(rr[1])); }
    pmax = keep ? pmax : -__builtin_inff();
    constexpr float C2 = 1.4426950408889634f * SCALE;
    if (__builtin_expect(__all((pmax - m_reg) * SCALE <= THR), 1)) { mn = m_reg; alpha = 1.f; }
    else { mn = fmaxf(m_reg, pmax); alpha = __builtin_amdgcn_exp2f((m_reg - mn) * C2); m_reg = mn; }
    const float mnL = keep ? -mn * C2 : -__builtin_inff();
#pragma unroll
    for (int r = 0; r < 16; ++r) p0[r] = fmaf(p0[r], C2, mnL);
#pragma unroll
    for (int r = 0; r < 16; ++r) p1[r] = fmaf(p1[r], C2, mnL);
#pragma unroll
    for (int r = 0; r < 16; ++r) p0[r] = __builtin_amdgcn_exp2f(p0[r]);
}
__device__ __forceinline__ void finishSM(f32x16& p0, f32x16& p1, float alpha, float& l_reg, bf16x8& pa0, bf16x8& pa1, bf16x8& pa2, bf16x8& pa3) {
#pragma unroll
    for (int r = 0; r < 16; ++r) p1[r] = __builtin_amdgcn_exp2f(p1[r]);
    float ps = 0;
#pragma unroll
    for (int r = 0; r < 16; ++r) ps += p0[r];
#pragma unroll
    for (int r = 0; r < 16; ++r) ps += p1[r];
    { auto rr = __builtin_amdgcn_permlane32_swap(__float_as_uint(ps), __float_as_uint(ps), false, false);
      ps = __uint_as_float(rr[0]) + __uint_as_float(rr[1]); }
    l_reg = l_reg * alpha + ps;
#define PK4(P, B_, OUT) do { unsigned a0 = cvtpk(P[B_+0], P[B_+1]), a1 = cvtpk(P[B_+2], P[B_+3]);                          \
        unsigned b0 = cvtpk(P[B_+4], P[B_+5]), b1 = cvtpk(P[B_+6], P[B_+7]);                                             \
        auto r0 = __builtin_amdgcn_permlane32_swap(a0, b0, false, false); auto r1 = __builtin_amdgcn_permlane32_swap(a1, b1, false, false); \
        u32x4 w = {r0[0], r1[0], r0[1], r1[1]}; OUT = *reinterpret_cast<bf16x8*>(&w); } while (0)
    PK4(p0, 0, pa0); PK4(p0, 8, pa1); PK4(p1, 0, pa2); PK4(p1, 8, pa3);
#undef PK4
}
template <int KB>
__device__ __forceinline__ void qkt(f32x16& p0, f32x16& p1, const char* K_lds, int r32, int hi, const bf16x8* qr) {
    p0 = f32x16{}; p1 = f32x16{};
    const char* kb[4];
#pragma unroll
    for (int dd = 0; dd < 4; ++dd) kb[dd] = K_lds + KB * SHM_K + KSWZ(r32, (dd * 16 + hi * 8) * 2);
#pragma unroll
    for (int d0 = 0; d0 < 8; ++d0) { const char* a = kb[d0 & 3] + (d0 >> 2) * 128;
        bf16x8 b0 = *reinterpret_cast<const bf16x8*>(a);
        bf16x8 b1 = *reinterpret_cast<const bf16x8*>(a + 32 * 256);
        p0 = __builtin_amdgcn_mfma_f32_32x32x16_bf16(b0, qr[d0], p0, 0, 0, 0);
        p1 = __builtin_amdgcn_mfma_f32_32x32x16_bf16(b1, qr[d0], p1, 0, 0, 0); }
}
template <int VB>
__device__ __forceinline__ void pv_tile(f32x16* o, int vb0, bf16x8 pa0, bf16x8 pa1, bf16x8 pa2, bf16x8 pa3) {
#define TRRD(dst, off) asm volatile("ds_read_b64_tr_b16 %0, %1 offset:%2" : "=&v"(dst) : "v"(vb0), "i"(off) : "memory")
#define PV_D0(d0) do { s16x4 l0, l1, l2, l3, h0, h1, h2, h3; constexpr int b_ = VB * SHM_V + v_rd_off(d0, 0, 0); \
        TRRD(l0, b_); TRRD(h0, b_ + 2048); TRRD(l1, b_ + 4096); TRRD(h1, b_ + 6144); TRRD(l2, b_ + 8192); TRRD(h2, b_ + 10240); TRRD(l3, b_ + 12288); TRRD(h3, b_ + 14336); \
        asm volatile("s_waitcnt lgkmcnt(0)" ::: "memory"); SBAR();   \
        o[d0] = __builtin_amdgcn_mfma_f32_32x32x16_bf16(pa0, (bf16x8){l0[0], l0[1], l0[2], l0[3], h0[0], h0[1], h0[2], h0[3]}, o[d0], 0, 0, 0);   \
        o[d0] = __builtin_amdgcn_mfma_f32_32x32x16_bf16(pa1, (bf16x8){l1[0], l1[1], l1[2], l1[3], h1[0], h1[1], h1[2], h1[3]}, o[d0], 0, 0, 0);   \
        o[d0] = __builtin_amdgcn_mfma_f32_32x32x16_bf16(pa2, (bf16x8){l2[0], l2[1], l2[2], l2[3], h2[0], h2[1], h2[2], h2[3]}, o[d0], 0, 0, 0);   \
        o[d0] = __builtin_amdgcn_mfma_f32_32x32x16_bf16(pa3, (bf16x8){l3[0], l3[1], l3[2], l3[3], h3[0], h3[1], h3[2], h3[3]}, o[d0], 0, 0, 0); } while (0)
    PV_D0(0); PV_D0(1); PV_D0(2); PV_D0(3);
#undef PV_D0
#undef TRRD
}

struct BlockRef { int qo, kvo, kmo, qb; };
struct Bases { const bf16_t* Q; const bf16_t* K; const bf16_t* V; bf16_t* O; const float* KS; };
__device__ __forceinline__ bf16x8 kmean8(const float* p, int lo) {
    const f32x4 a = *(const f32x4*)p * (1.0f / 256.0f), b = *(const f32x4*)(p + 4) * (1.0f / 256.0f);
    const float v[8] = {a[0], a[1], a[2], a[3], b[0], b[1], b[2], b[3]}; unsigned short o[8];
#pragma unroll
    for (int e = 0; e < 8; ++e) { const unsigned h = f2bf(v[e]); o[e] = (unsigned short)(lo ? f2bf(v[e] - __uint_as_float(h << 16)) : h); }
    return (bf16x8){(short)o[0], (short)o[1], (short)o[2], (short)o[3], (short)o[4], (short)o[5], (short)o[6], (short)o[7]};
}
struct Seam { bf16x8 qr[8]; bf16x8 st_v0, st_v1, st_k0, st_k1; };

#define ROW(p, k0, rr) ((p) + (size_t)((k0) + (rr)) * LD + sc)
#define VMW() asm volatile("s_waitcnt vmcnt(0)" ::: "memory")
#define VMWN(n) asm volatile("s_waitcnt vmcnt(%0)" :: "i"(n) : "memory")
#define SLOAD_H(Kp, Vp, k0) do { S.st_v0 = load8(ROW(Vp, k0, sr)); S.st_v1 = load8(ROW(Vp, k0, 32 + sr));              \
                         S.st_k0 = load8(ROW(Kp, k0, sr)); S.st_k1 = load8(ROW(Kp, k0, 32 + sr)); } while (0)
#define SWRITE_HK(bf) do { *(bf16x8*)(K_lds + (bf) * SHM_K + kws) = S.st_k0; *(bf16x8*)(K_lds + (bf) * SHM_K + kws + 32 * 256) = S.st_k1; } while (0)
#define SWRITE_HV(bf) do { *(bf16x8*)(V_lds + (bf) * SHM_V + vst0) = S.st_v0; *(bf16x8*)(V_lds + (bf) * SHM_V + vst1) = S.st_v1; } while (0)
#define SWRITE_H(bf) do { SWRITE_HV(bf); SWRITE_HK(bf); } while (0)
#define GLOAD(ref, tq) (kmean8(BP.KS + (size_t)(ref).kmo + (size_t)(((tq) & 255) >> 4) * LD + ((tq) & 15) * 8, (tq) >> 8))
#define GWRITE(val, tq) do { *(bf16x8*)(lds + G_OFF + ((tq) >> 8) * 4096 + KSWZ(((tq) & 255) >> 4, ((tq) & 15) * 16)) = (val); } while (0)

__device__ __forceinline__ void moba_prime(const Bases& BP, const BlockRef& cur, char* lds, Seam& S) {
    const int tid = opaque_tid(), wid = __builtin_amdgcn_readfirstlane(tid >> 6), lane = tid & 63, r32 = lane & 31, hi = lane >> 5;
    const int sr = tid >> 4, sc = (tid & 15) * 8, kws = KSWZ(sr, sc * 2); char* K_lds = lds + 2 * SHM_V;
#pragma unroll
    for (int d0 = 0; d0 < 8; ++d0) S.qr[d0] = load8(BP.Q + (size_t)cur.qo + (size_t)(wid * QBLK + r32) * LD + d0 * 16 + hi * 8);
    const bf16x8 gv = GLOAD(cur, tid);
    SLOAD_H(BP.K + (size_t)cur.kvo, BP.V + (size_t)cur.kvo, 0); VMW(); SWRITE_HK(0); GWRITE(gv, tid);
    __syncthreads();
}
__device__ __forceinline__ void moba_block(const Bases& BP, const BlockRef& cur, const BlockRef& nxt, char* lds, Seam& S) {
    int tid_ = threadIdx.x; asm volatile("" : "+v"(tid_));
    const int tid = tid_, wid = __builtin_amdgcn_readfirstlane(tid >> 6), lane = tid & 63, r32 = lane & 31, hi = lane >> 5;
    const int P0 = cur.qb * QB;
    const int NT = (cur.qb + 1) * 4;
    const int qlo = P0 + wid * QBLK, qm = qlo + r32 - 4 * hi;
    char* V_lds = lds; char* K_lds = lds + 2 * SHM_V;
    float* ws = (float*)(lds + 2 * SHM_V + 2 * SHM_K) + wid * 64; float* li_l = ws, * al_l = ws + 32;
    int sel;
    if (cur.qb <= 3) sel = (1 << cur.qb) - 1;
    else {
        f32x16 g = f32x16{};
        const char* gb = lds + G_OFF;
#pragma unroll
        for (int d0 = 0; d0 < 8; ++d0) { const int off = KSWZ(r32 & 15, (d0 * 16 + hi * 8) * 2);
            const bf16x8 ah = *reinterpret_cast<const bf16x8*>(gb + off), al = *reinterpret_cast<const bf16x8*>(gb + 4096 + off);
            g = __builtin_amdgcn_mfma_f32_32x32x16_bf16(ah, S.qr[d0], g, 0, 0, 0);
            g = __builtin_amdgcn_mfma_f32_32x32x16_bf16(al, S.qr[d0], g, 0, 0, 0); }
        float s[16];
#pragma unroll
        for (int r = 0; r < 8; ++r) { const float mine = g[r]; const float other = __shfl_xor(mine, 32);
            const int b0 = (r & 3) + 8 * (r >> 2);
            s[b0] = hi ? other : mine; s[b0 + 4] = hi ? mine : other; }
        sel = 0;
#pragma unroll
        for (int round = 0; round < 3; ++round) { float best = -__builtin_inff(); int bi = 0;
#pragma unroll
            for (int j = 0; j < 16; ++j) { const bool ok = (j < cur.qb) && !((sel >> j) & 1); const float v = ok ? s[j] : -__builtin_inff(); if (v > best) { best = v; bi = j; } }
            sel |= 1 << bi; }
    }
    float m_reg = -1e30f, l_reg = 0; f32x16 o[4] = {};
    const int sr = tid >> 4, sc = (tid & 15) * 8, vst0 = v_st(sr, sc), vst1 = v_st(32 + sr, sc), kws = KSWZ(sr, sc * 2);
    const int vb0 = (int)(uintptr_t)V_lds + v_rd_base(lane);
    const bf16_t* Kh = BP.K + (size_t)cur.kvo; const bf16_t* Vh = BP.V + (size_t)cur.kvo;
#define RESC(a) do { if (__any((a) < 1.f)) { if (hi == 0) al_l[r32] = (a); asm volatile("s_waitcnt lgkmcnt(0)" ::: "memory");              \
                     for (int d_ = 0; d_ < 4; ++d_) for (int r = 0; r < 16; ++r) o[d_][r] *= al_l[crow(r, hi)]; } } while (0)
#define KBASE(t) ((t) * KVBLK)
#define MASKT(P0_, P1_, t) do { const int kb_ = KBASE(t); if (kb_ >= P0 && kb_ + KVBLK - 1 > qlo) mask_tile(P0_, P1_, qm - kb_); } while (0)
#define KEEPT(t) ((KBASE(t) >= P0) || ((sel >> (KBASE(t) >> 8)) & 1))
    constexpr int NQL = 8;
#define SEAM_K0() do { VMWN(NQL); SWRITE_HK(0); SBAR(); } while (0)
    f32x16 pA0, pA1, pB0, pB1; float mnA, mnB, alA, alB; bf16x8 pa0, pa1, pa2, pa3;
    SWRITE_HV(0); SBAR();
    if (NT > 1) { SLOAD_H(Kh, Vh, KBASE(1)); }
    SBAR(); qkt<0>(pA0, pA1, K_lds, r32, hi, S.qr);
    MASKT(pA0, pA1, 0); partialSM(pA0, pA1, m_reg, mnA, alA, KEEPT(0));
    if (NT > 1) { VMW(); SWRITE_H(1); }
    __syncthreads();
#define HALF_STEP(PX0, PX1, mnX, alX, PY0, PY1, alY, t, KB, VB, SB) do {                                                      \
        SBAR(); qkt<KB>(PX0, PX1, K_lds, r32, hi, S.qr);                                             \
        finishSM(PY0, PY1, alY, l_reg, pa0, pa1, pa2, pa3); SBAR();                                                           \
        if ((t) + 1 < NT) { SLOAD_H(Kh, Vh, KBASE((t) + 1)); SBAR(); }                                               \
        pv_tile<VB>(o, vb0, pa0, pa1, pa2, pa3); MASKT(PX0, PX1, (t)); partialSM(PX0, PX1, m_reg, mnX, alX, KEEPT(t));                                        \
        __syncthreads();                                                                                                      \
        if ((t) + 1 < NT) { VMW(); SWRITE_H(SB); }                                                                          \
        RESC(alX); __syncthreads(); } while (0)
    for (int t = 1; t + 1 < NT; t += 2) {
        HALF_STEP(pB0, pB1, mnB, alB, pA0, pA1, alA, t, 1, 0, 0);
        HALF_STEP(pA0, pA1, mnA, alA, pB0, pB1, alB, t + 1, 0, 1, 1);
    }
    const bool even = (NT & 1) == 0;
    if (even) { SBAR(); qkt<1>(pB0, pB1, K_lds, r32, hi, S.qr); SBAR(); }
    SLOAD_H(BP.K + (size_t)nxt.kvo, BP.V + (size_t)nxt.kvo, 0); SBAR();
    int tz = threadIdx.x; asm volatile("" : "+v"(tz));
    const int widz = __builtin_amdgcn_readfirstlane(tz >> 6), r32z = tz & 31, hiz = (tz >> 5) & 1;
    { const bf16_t* qn = BP.Q + (size_t)nxt.qo + (size_t)(widz * QBLK + r32z) * LD + hiz * 8;
#pragma unroll
      for (int d0 = 0; d0 < 8; ++d0) S.qr[d0] = load8(qn + d0 * 16); }
    SBAR();
    finishSM(pA0, pA1, alA, l_reg, pa0, pa1, pa2, pa3); SBAR();
    pv_tile<0>(o, vb0, pa0, pa1, pa2, pa3);
    if (even) { MASKT(pB0, pB1, NT - 1); partialSM(pB0, pB1, m_reg, mnB, alB, KEEPT(NT - 1)); __syncthreads(); RESC(alB);
        finishSM(pB0, pB1, alB, l_reg, pa0, pa1, pa2, pa3); SBAR(); pv_tile<1>(o, vb0, pa0, pa1, pa2, pa3); }
    SBAR(); SEAM_K0();
    const bf16x8 gnext = GLOAD(nxt, tz);
    if (hiz == 0) li_l[r32z] = l_reg; asm volatile("s_waitcnt lgkmcnt(0)" ::: "memory");
    float rli[16];
#pragma unroll
    for (int r = 0; r < 16; ++r) rli[r] = __builtin_amdgcn_rcpf(li_l[crow(r, hiz)]);
#if FP8_OUT
    { const int lanez = tz & 63; char* ost = lds + LDS_ATT + widz * 4096;
#pragma unroll
      for (int r = 0; r < 16; ++r) { const int orow = (r & 3) + 8 * (r >> 2) + 4 * hiz; const float sc = rli[r] * YMIX_SC;
#pragma unroll
          for (int d0 = 0; d0 < 4; ++d0) { const float v = o[d0][r] * sc; *(unsigned char*)(ost + orow * 128 + d0 * 32 + r32z) = (unsigned char)__builtin_amdgcn_cvt_pk_fp8_f32(v, v, 0, false); } }
      asm volatile("s_waitcnt lgkmcnt(0)" ::: "memory");
      unsigned char* Og = (unsigned char*)BP.O + (size_t)cur.qo + (size_t)(widz * QBLK + (lanez >> 3)) * LD + (lanez & 7) * 16;
      u32x4 w4[4];
#pragma unroll
      for (int q4 = 0; q4 < 4; ++q4) w4[q4] = *(const u32x4*)(ost + ((lanez >> 3) + 8 * q4) * 128 + (lanez & 7) * 16);
#pragma unroll
      for (int q4 = 0; q4 < 4; ++q4) *(u32x4*)(Og + (size_t)(8 * q4) * LD) = w4[q4];
      asm volatile("s_waitcnt lgkmcnt(0)" ::: "memory"); }
#else
    bf16_t* Ow = BP.O + (size_t)cur.qo + (size_t)(widz * QBLK + 4 * hiz) * LD + r32z;
#pragma unroll
    for (int r = 0; r < 16; ++r) { const int orow = (r & 3) + 8 * (r >> 2);
#pragma unroll
        for (int d0 = 0; d0 < 4; ++d0) { const float v = o[d0][r] * rli[r];
            const float vn = __shfl_xor(v, 1);
            if ((r32z & 1) == 0) *(unsigned*)(Ow + (size_t)orow * LD + d0 * 32) = cvtpk(v, vn); } }
#endif
    GWRITE(gnext, tz);
    __syncthreads();
#undef RESC
#undef KBASE
#undef MASKT
#undef KEEPT
#undef SEAM_K0
#undef HALF_STEP
}
#undef ROW
#undef VMW
#undef VMWN
#undef SLOAD_H
#undef SWRITE_HK
#undef SWRITE_HV
#undef SWRITE_H
#undef GLOAD
#undef GWRITE

__device__ __forceinline__ bool item_of(int c, int G, int i, int& bh, int& x) {
    if (G == 256) { const int s = (c >> 3) + 32 * i; if (s >= 64) return false; bh = (c & 7) + 8 * (s >> 3); x = s & 7; return true; }
    const int L = c + i * G; if (L >= 512) return false; bh = L >> 3; x = L & 7; return true;
}
__device__ __forceinline__ BlockRef ref_of(int bh, int qb) {
    const int b = bh >> 3, h = bh & 7; BlockRef r;
    r.qo = (b * SEQ + qb * QB) * LD + h * HD; r.kvo = b * SEQ * LD + h * HD; r.kmo = b * 16 * LD + h * HD; r.qb = qb;
    return r;
}
__device__ __forceinline__ void attn_phase(char* lds, const Bases& BP, int G, int c) {
    int it = 0, bh, x; if (!item_of(c, G, 0, bh, x)) return;
    int pass = 0;
    BlockRef cur = ref_of(bh, x);
    Seam S;
    moba_prime(BP, cur, lds, S);
    for (;;) {
        int bhn = bh, xn = x, passn = pass + 1, itn = it; bool last = false;
        if (pass == 1) { passn = 0; itn = it + 1; if (!item_of(c, G, itn, bhn, xn)) { last = true; bhn = bh; xn = x; passn = pass; itn = it; } }
        const BlockRef nxt = last ? cur : ref_of(bhn, passn ? 15 - xn : xn);
        moba_block(BP, cur, nxt, lds, S);
        if (last) break;
        cur = nxt; bh = bhn; x = xn; pass = passn; it = itn;
    }
}
}

struct Args { const float* in[22]; float* out; unsigned char* ws; };

__device__ __forceinline__ int rowmap(int mode, int n) {
    if (mode == 1) { const int g = n >> 10, m = n & 1023; return ((m >> 7) << 8) + (g << 7) + (m & 127); }
    if (mode == 2) { if (n >= 2048) return n; const int d = n & 127, dd = d & 63; return (n & ~127) + ((dd >> 4) << 5) + (((dd >> 2) & 3) << 3) + ((d >> 6) << 2) + (d & 3); }
    return n;
}
struct CvItem { const float* W; bf16_t* WT; int N, ldk, koff, row_off, mode, kb, nb; float f8scale; };
__device__ __forceinline__ const float* arg_ptr(int k);
constexpr int CV_SMALL = 2 * 512 + 2 * 256 + 2 * 256 + 2 * 768 + 2 * 8 * 2 * 4;
constexpr int CV_MOE = 32 * 512 + 32 * 256;
__device__ __forceinline__ CvItem cv_small(unsigned char* ws, int r) {
    CvItem c; c.ldk = 1024; c.koff = 0; c.row_off = 0; c.mode = 0; c.f8scale = 0.f;
    constexpr int I_IN = 2 * 512, I_OUTR = 2 * 256, I_O = 2 * 256, I_QKV = 2 * 768;
    if (r < I_IN) { const int mat = r >> 9, rr = r & 511; c.W = arg_ptr(5) + (size_t)mat * 1024 * 2048; c.N = 2048; c.WT = (bf16_t*)(ws + WS_WIN) + (size_t)mat * 2048 * 1024; c.kb = rr >> 6; c.nb = rr & 63; if (FP8_IN) { c.f8scale = 32.0f; c.WT = (bf16_t*)(ws + WS_WIN + (size_t)mat * 2048 * 1024); } }
    else if ((r -= I_IN) < I_OUTR) { const int mat = r >> 8, rr = r & 255; c.W = arg_ptr(13) + (size_t)mat * 1024 * 1024; c.N = 1024; c.WT = (bf16_t*)(ws + WS_WOUT) + (size_t)(2 * mat) * 1024 * 1024; c.kb = rr >> 5; c.nb = rr & 31; if (FP8_OUT) { c.f8scale = 32.0f; c.WT = (bf16_t*)(ws + WS_WOUT + (size_t)(2 * mat) * 1024 * 1024); } }
    else if ((r -= I_OUTR) < I_O) { const int mat = r >> 8, rr = r & 255; c.W = arg_ptr(15) + (size_t)mat * 1024 * 1024; c.N = 1024; c.WT = (bf16_t*)(ws + WS_WOUT) + (size_t)(2 * mat + 1) * 1024 * 1024; c.kb = rr >> 5; c.nb = rr & 31; if (FP8_OUT) { c.f8scale = 32.0f; c.WT = (bf16_t*)(ws + WS_WOUT + (size_t)(2 * mat + 1) * 1024 * 1024); } }
    else if ((r -= I_O) < I_QKV) { const int mat = r / 768, rr = r % 768; c.W = arg_ptr(14) + (size_t)mat * 1024 * 3072; c.N = 3072; c.WT = (bf16_t*)(ws + WS_WQKV) + (size_t)mat * 3072 * 1024; c.kb = rr / 96; c.nb = rr % 96; c.mode = 2; if (FP8_QKV) { c.f8scale = 32.0f; c.WT = (bf16_t*)(ws + WS_WQKV + (size_t)mat * 3072 * 1024); } }
    else { r -= I_QKV; const int rr = r & 3, m2 = r >> 2, which = m2 & 1, h = (m2 >> 1) & 7, l = m2 >> 4;
        c.W = arg_ptr(which ? 10 : 8) + (size_t)(l * 8 + h) * 128 * 128; c.N = 128; c.WT = (bf16_t*)(ws + WS_WGATE) + (size_t)(l * 8 + h) * 256 * 128; c.ldk = 128; c.row_off = 128 * which; c.kb = 0; c.nb = rr; }
    return c;
}
__device__ __forceinline__ CvItem cv_moe(unsigned char* ws, int layer, int r) {
    CvItem c; c.ldk = 1024; c.koff = 0; c.row_off = 0; c.f8scale = 0.f;
    if (r < 32 * 512) { const int mat = layer * 32 + (r >> 9), rr = r & 511; c.W = arg_ptr(18) + (size_t)mat * 1024 * 2048; c.N = 2048; c.WT = (bf16_t*)(ws + WS_WGU) + (size_t)mat * 2048 * 1024; c.kb = rr >> 6; c.nb = rr & 63; c.mode = 1; if (FP8_GU) { c.f8scale = 32.0f; c.WT = (bf16_t*)(ws + WS_WGU + (size_t)mat * 2048 * 1024); } }
    else { r -= 32 * 512; const int mat = layer * 32 + (r >> 8), rr = r & 255; c.W = arg_ptr(20) + (size_t)mat * 1024 * 1024; c.N = 1024; c.WT = (bf16_t*)(ws + WS_WDN) + (size_t)mat * 1024 * 1024; c.kb = rr >> 5; c.nb = rr & 31; c.mode = 0; if (FP8_DN) { c.f8scale = 64.0f; c.WT = (bf16_t*)(ws + WS_WDN + (size_t)mat * 1024 * 1024); } }
    return c;
}
__device__ __forceinline__ void cv_load(const CvItem& c, int lane, f32x4 (&v)[16]) {
    const float* ub = c.W + (size_t)(128 * c.kb) * c.N + 32 * c.nb;
    const unsigned lo = ((unsigned)(lane >> 3) * (unsigned)c.N + 4u * (lane & 7)) * 4u;
#pragma unroll
    for (int i = 0; i < 16; ++i) v[i] = __builtin_nontemporal_load((const f32x4*)((const char*)(ub + (size_t)(8 * i) * c.N) + lo));
}
__device__ __forceinline__ void cv_put(int lane, const f32x4 (&v)[16], LAS float* scr) {
#pragma unroll
    for (int i = 0; i < 16; ++i) { LAS float* d = scr + i * 266 + (lane >> 3) * 33 + 4 * (lane & 7); d[0] = v[i][0]; d[1] = v[i][1]; d[2] = v[i][2]; d[3] = v[i][3]; }
    LDS_WAIT(); asm volatile("" ::: "memory");
}
__device__ __forceinline__ void cv_emit(const CvItem& c, int lane, LAS float* scr) {
    const int cc = lane & 15;
#pragma unroll
    for (int j = 0; j < 8; ++j) { const int n = (lane >> 4) + 4 * j; const LAS float* s = scr + cc * 266 + n;
        const unsigned eo = (unsigned)rowmap(c.mode, 32 * c.nb + n) * (unsigned)c.ldk + 8u * cc;
        if (c.f8scale != 0.f) { const float q = c.f8scale; u32x2 o; o.x = pk4_fp8(s[0 * 33] * q, s[1 * 33] * q, s[2 * 33] * q, s[3 * 33] * q); o.y = pk4_fp8(s[4 * 33] * q, s[5 * 33] * q, s[6 * 33] * q, s[7 * 33] * q);
            *(u32x2*)((unsigned char*)c.WT + ((size_t)c.row_off * c.ldk + c.koff + 128 * c.kb) + eo) = o; }
        else { u32x4 o; o.x = pk2(s[0 * 33], s[1 * 33]); o.y = pk2(s[2 * 33], s[3 * 33]); o.z = pk2(s[4 * 33], s[5 * 33]); o.w = pk2(s[6 * 33], s[7 * 33]);
            *(u32x4*)((unsigned char*)(c.WT + ((size_t)c.row_off * c.ldk + c.koff + 128 * c.kb)) + 2u * eo) = o; } }
    LDS_WAIT(); asm volatile("" ::: "memory");
}
__device__ __forceinline__ void cv_store(const CvItem& c, int lane, const f32x4 (&v)[16], LAS float* scr) { cv_put(lane, v, scr); cv_emit(c, lane, scr); }
__device__ __forceinline__ void cv8_cvt(float q, const f32x4 (&v)[16], unsigned (&w)[16]) {
#pragma unroll
    for (int i = 0; i < 16; ++i) { const f32x4 t = v[i] * q; w[i] = pk4_fp8(t[0], t[1], t[2], t[3]); }
}
__device__ __forceinline__ void cv8_put(int lane, const unsigned (&w)[16], LAS unsigned* scr) {
    LAS unsigned* d = scr + 32 * (lane >> 5) + 4 * (lane & 7) + ((lane >> 3) & 3);
#pragma unroll
    for (int i = 0; i < 16; ++i) d[160 * (i >> 1) + 64 * (i & 1)] = w[i];
    LDS_WAIT(); asm volatile("" ::: "memory");
}
__device__ __forceinline__ void cv8_emit(const CvItem& c, int lane, LAS unsigned* scr) {
    const int ng = lane & 7, kgg = lane >> 3;
    u32x4 r[4];
#pragma unroll
    for (int t = 0; t < 4; ++t) r[t] = *(const LAS u32x4*)(scr + 160 * kgg + 32 * t + 4 * ng);
    LDS_WAIT(); asm volatile("" ::: "memory");
    u32x4 o[4];
#pragma unroll
    for (int t = 0; t < 4; ++t) {
        const unsigned t0 = __builtin_amdgcn_perm(r[t][1], r[t][0], 0x05010400u), t1 = __builtin_amdgcn_perm(r[t][1], r[t][0], 0x07030602u);
        const unsigned t2 = __builtin_amdgcn_perm(r[t][3], r[t][2], 0x05010400u), t3 = __builtin_amdgcn_perm(r[t][3], r[t][2], 0x07030602u);
        o[0][t] = __builtin_amdgcn_perm(t2, t0, 0x05040100u); o[1][t] = __builtin_amdgcn_perm(t2, t0, 0x07060302u);
        o[2][t] = __builtin_amdgcn_perm(t3, t1, 0x05040100u); o[3][t] = __builtin_amdgcn_perm(t3, t1, 0x07060302u); }
    unsigned char* wb = (unsigned char*)c.WT + ((size_t)c.row_off * c.ldk + c.koff + 128 * c.kb);
#pragma unroll
    for (int j = 0; j < 4; ++j) { const unsigned eo = (unsigned)rowmap(c.mode, 32 * c.nb + 4 * ng + j) * (unsigned)c.ldk + 16u * kgg;
        __builtin_nontemporal_store(o[j], (u32x4*)(wb + eo)); }
}
__device__ __forceinline__ void cv_moe_range(unsigned char* ws, LAS unsigned char* lds, int layer, int lo, int hi, int G, int wg = -1) {
    const int tid = opaque_tid(), lane = tid & 63, wave = __builtin_amdgcn_readfirstlane(tid >> 6);
    const int gw = (wg < 0 ? (int)blockIdx.x : wg) * 8 + wave, NGW = G * 8;
    int it = lo + gw; if (it >= hi) return;
    f32x4 vA[16], vB[16]; CvItem cA, cB, cE;
#define CV_LD(c, v, idx) do { const int i_ = (idx); const bool h_ = i_ < hi; c = cv_moe(ws, layer, h_ ? i_ : it); if (h_) cv_load(c, lane, v); } while (0)
    CV_LD(cA, vA, it); CV_LD(cB, vB, it + NGW);
#if FP8_GU && FP8_DN
    LAS unsigned* scr = (LAS unsigned*)(lds + wave * CV_SCR);
    unsigned w[16];
    for (;;) {
        cv8_cvt(cA.f8scale, vA, w); cE = cA; CV_LD(cA, vA, it + 2 * NGW); cv8_put(lane, w, scr); cv8_emit(cE, lane, scr); if (it + NGW >= hi) break;
        cv8_cvt(cB.f8scale, vB, w); cE = cB; CV_LD(cB, vB, it + 3 * NGW); cv8_put(lane, w, scr); cv8_emit(cE, lane, scr); if (it + 2 * NGW >= hi) break;
        it += 2 * NGW;
    }
#else
    LAS float* scr = (LAS float*)(lds + wave * CV_SCR);
    for (;;) {
        cv_put(lane, vA, scr); cE = cA; CV_LD(cA, vA, it + 2 * NGW); cv_emit(cE, lane, scr); if (it + NGW >= hi) break;
        cv_put(lane, vB, scr); cE = cB; CV_LD(cB, vB, it + 3 * NGW); cv_emit(cE, lane, scr); if (it + 2 * NGW >= hi) break;
        it += 2 * NGW;
    }
#endif
#undef CV_LD
}
__device__ __forceinline__ void cv_idle_slot(unsigned char* ws, LAS unsigned char* lds, int layer, int quota) {
    if (layer >= DEPTH) return;
    const int tid = opaque_tid(), lane = tid & 63, wave = __builtin_amdgcn_readfirstlane(tid >> 6);
    LAS float* scr = (LAS float*)(lds + wave * CV_SCR);
    unsigned* ctr = (unsigned*)(ws + WS_CTL) + 8192 + 64 * layer;
    for (int q = 0; q < quota; ++q) {
        unsigned it = 0; if (lane == 0) it = __hip_atomic_fetch_add(ctr, 2u, __ATOMIC_RELAXED, __HIP_MEMORY_SCOPE_AGENT);
        it = (unsigned)__builtin_amdgcn_readfirstlane((int)it);
        if (it >= (unsigned)CV_MOE) break;
        const CvItem c0 = cv_moe(ws, layer, (int)it), c1 = cv_moe(ws, layer, (int)it + 1);
        f32x4 v0[16], v1[16]; cv_load(c0, lane, v0); cv_load(c1, lane, v1);
        cv_store(c0, lane, v0, scr); cv_store(c1, lane, v1, scr);
    }
}
__device__ __forceinline__ void cv_cleanup(unsigned char* ws, LAS unsigned char* lds, int layer, int G) {
    unsigned done = __hip_atomic_load((unsigned*)(ws + WS_CTL) + 8192 + 64 * layer, __ATOMIC_RELAXED, __HIP_MEMORY_SCOPE_AGENT);
    done = (unsigned)__builtin_amdgcn_readfirstlane((int)done);
    if (done < (unsigned)CV_MOE) cv_moe_range(ws, lds, layer, (int)done, CV_MOE, G);
}

__device__ __forceinline__ void prologue_phase(LAS unsigned char* lds, int G) {
    unsigned char* ws = (unsigned char*)arg_ptr(23);
    const int tid = opaque_tid(), lane = tid & 63, wave = __builtin_amdgcn_readfirstlane(tid >> 6);
    LAS float* scr = (LAS float*)(lds + wave * CV_SCR);
    const int gw = blockIdx.x * 8 + wave, NGW = G * 8;
    for (int it = gw; it < CV_SMALL; it += NGW) { const CvItem c = cv_small(ws, it); f32x4 v[16]; cv_load(c, lane, v); cv_store(c, lane, v, scr); }
    cv_moe_range(ws, lds, 0, 0, CV_MOE, G);
    const size_t gt = (size_t)blockIdx.x * 512 + tid, NGT = (size_t)G * 512;
    { int4* rt4 = (int4*)(ws + WS_ROWTOK); for (size_t i = gt; i < (size_t)NE * RT_CAP / 4; i += NGT) rt4[i] = make_int4(0, 0, 0, 0); }
    const float* x = arg_ptr(0); bf16_t* xb = (bf16_t*)(ws + WS_XBF);
    for (size_t i0 = gt; i0 < (size_t)T * D / 8; i0 += 4 * NGT) { f32x4 v0[4], v1[4];
#pragma unroll
        for (int u = 0; u < 4; ++u) { const size_t i = i0 + u * NGT; if (i < (size_t)T * D / 8) { v0[u] = *(const f32x4*)(x + i * 8); v1[u] = *(const f32x4*)(x + i * 8 + 4); } }
#pragma unroll
        for (int u = 0; u < 4; ++u) { const size_t i = i0 + u * NGT; if (i < (size_t)T * D / 8) { u32x4 w; w.x = pk2(v0[u][0], v0[u][1]); w.y = pk2(v0[u][2], v0[u][3]); w.z = pk2(v1[u][0], v1[u][1]); w.w = pk2(v1[u][2], v1[u][3]); *(u32x4*)(xb + i * 8) = w;
            if (FP8_X) { u32x2 q; q.x = pk4_fp8(v0[u][0], v0[u][1], v0[u][2], v0[u][3]); q.y = pk4_fp8(v1[u][0], v1[u][1], v1[u][2], v1[u][3]); *(u32x2*)(ws + WS_XF8 + i * 8) = q; } } } }
}

__device__ __forceinline__ void conv_phase(const bf16_t* rec, bf16_t* ub, const float* cw, const float* cb, int G) {
    const int tid = opaque_tid(), cg = tid & 127, rs = tid >> 7;
    float w[4][8], bias[8];
#pragma unroll
    for (int j = 0; j < 4; ++j) { const f32x4 a0 = *(const f32x4*)(cw + j * D + cg * 8), a1 = *(const f32x4*)(cw + j * D + cg * 8 + 4);
#pragma unroll
        for (int e = 0; e < 4; ++e) { w[j][e] = a0[e]; w[j][4 + e] = a1[e]; } }
    { const f32x4 a0 = *(const f32x4*)(cb + cg * 8), a1 = *(const f32x4*)(cb + cg * 8 + 4);
#pragma unroll
      for (int e = 0; e < 4; ++e) { bias[e] = a0[e]; bias[4 + e] = a1[e]; } }
    for (int tile = blockIdx.x; tile < T / 128; tile += G) {
        const int t0 = tile * 128 + rs * 32; const bool seq_start = (t0 & (SEQ - 1)) == 0;
        float p[3][8];
#pragma unroll
        for (int k = 0; k < 3; ++k) { u32x4 v = (u32x4){0u, 0u, 0u, 0u}; if (!seq_start) v = *(const u32x4*)(rec + (size_t)(t0 - 3 + k) * D + cg * 8);
            p[k][0] = bflo(v.x); p[k][1] = bfhi(v.x); p[k][2] = bflo(v.y); p[k][3] = bfhi(v.y); p[k][4] = bflo(v.z); p[k][5] = bfhi(v.z); p[k][6] = bflo(v.w); p[k][7] = bfhi(v.w); }
        for (int r0 = 0; r0 < 32; r0 += 8) { u32x4 vin[8];
#pragma unroll
          for (int rr = 0; rr < 8; ++rr) vin[rr] = *(const u32x4*)(rec + (size_t)(t0 + r0 + rr) * D + cg * 8);
#pragma unroll
          for (int rr = 0; rr < 8; ++rr) { const int r = r0 + rr; const u32x4 v = vin[rr];
            float c[8] = {bflo(v.x), bfhi(v.x), bflo(v.y), bfhi(v.y), bflo(v.z), bfhi(v.z), bflo(v.w), bfhi(v.w)}; float o[8];
#pragma unroll
            for (int e = 0; e < 8; ++e) { o[e] = bias[e] + w[0][e] * p[0][e] + w[1][e] * p[1][e] + w[2][e] * p[2][e] + w[3][e] * c[e]; p[0][e] = p[1][e]; p[1][e] = p[2][e]; p[2][e] = c[e]; }
            u32x4 ow; ow.x = pk2(o[0], o[1]); ow.y = pk2(o[2], o[3]); ow.z = pk2(o[4], o[5]); ow.w = pk2(o[6], o[7]);
            *(u32x4*)(ub + (size_t)(t0 + r) * D + cg * 8) = ow; } }
    }
}

__device__ __forceinline__ void scan1_phase(const bf16_t* la, const bf16_t* bb, float* agg, int G) {
    const int tid = opaque_tid();
    for (int unit = blockIdx.x; unit < 256; unit += G) {
        const size_t base = (size_t)unit * 128 * D + 2 * tid;
        float h0 = 0.f, h1 = 0.f, s0 = 0.f, s1 = 0.f;
        for (int t0 = 0; t0 < 128; t0 += 32) { unsigned lw[32], bw[32];
#pragma unroll
            for (int t = 0; t < 32; ++t) { lw[t] = *(const unsigned*)(la + base + (size_t)(t0 + t) * D); bw[t] = FP8_SCAN ? (unsigned)*(const unsigned short*)((const unsigned char*)bb + base + (size_t)(t0 + t) * D) : *(const unsigned*)(bb + base + (size_t)(t0 + t) * D); }
#pragma unroll
            for (int t = 0; t < 32; ++t) { const float l0 = bflo(lw[t]), l1 = bfhi(lw[t]); float b0, b1;
                if (FP8_SCAN) { const f32x2 b2 = __builtin_amdgcn_cvt_pk_f32_fp8((int)bw[t], false); b0 = b2[0]; b1 = b2[1]; } else { b0 = bflo(bw[t]); b1 = bfhi(bw[t]); }
                h0 = __expf(l0) * h0 + b0; h1 = __expf(l1) * h1 + b1; s0 += l0; s1 += l1; } }
        *(f32x4*)(agg + ((size_t)unit * D + 2 * tid) * 2) = (f32x4){__expf(s0), h0, __expf(s1), h1};
    }
}
__device__ __forceinline__ void scan2_phase(const bf16_t* la, const bf16_t* bb, const float* agg, const bf16_t* gg, bf16_t* y, int G) {
    const int tid = opaque_tid();
    for (int unit = blockIdx.x; unit < 256; unit += G) {
        const int chunk = unit & 31; const size_t base = (size_t)unit * 128 * D + 2 * tid;
        float h0 = 0.f, h1 = 0.f;
        const float* ag = agg + ((size_t)(unit - chunk) * D + 2 * tid) * 2;
#pragma unroll 8
        for (int jc = 0; jc < chunk; ++jc) { const f32x4 a = *(const f32x4*)(ag + (size_t)jc * D * 2); h0 = a[0] * h0 + a[1]; h1 = a[2] * h1 + a[3]; }
        for (int t0 = 0; t0 < 128; t0 += 16) { unsigned lw[16], bw[16], gw[16];
#pragma unroll
            for (int t = 0; t < 16; ++t) { lw[t] = *(const unsigned*)(la + base + (size_t)(t0 + t) * D);
                if (FP8_SCAN) { bw[t] = *(const unsigned short*)((const unsigned char*)bb + base + (size_t)(t0 + t) * D); gw[t] = *(const unsigned short*)((const unsigned char*)gg + base + (size_t)(t0 + t) * D); }
                else { bw[t] = *(const unsigned*)(bb + base + (size_t)(t0 + t) * D); gw[t] = *(const unsigned*)(gg + base + (size_t)(t0 + t) * D); } }
#pragma unroll
            for (int t = 0; t < 16; ++t) {
#if FP8_SCAN
                { const f32x2 b2 = __builtin_amdgcn_cvt_pk_f32_fp8((int)bw[t], false), g2 = __builtin_amdgcn_cvt_pk_f32_fp8((int)gw[t], false);
                  h0 = __expf(bflo(lw[t])) * h0 + b2[0]; h1 = __expf(bfhi(lw[t])) * h1 + b2[1];
                  *(unsigned short*)((unsigned char*)y + base + (size_t)(t0 + t) * D) = (unsigned short)__builtin_amdgcn_cvt_pk_fp8_f32(h0 * g2[0] * (YMIX_SC / (SCAN_SC * SCAN_SC)), h1 * g2[1] * (YMIX_SC / (SCAN_SC * SCAN_SC)), 0, false); }
                continue;
#endif
                h0 = __expf(bflo(lw[t])) * h0 + bflo(bw[t]); h1 = __expf(bfhi(lw[t])) * h1 + bfhi(bw[t]);
                if (FP8_OUT) *(unsigned short*)((unsigned char*)y + base + (size_t)(t0 + t) * D) = (unsigned short)__builtin_amdgcn_cvt_pk_fp8_f32(h0 * bflo(gw[t]) * YMIX_SC, h1 * bfhi(gw[t]) * YMIX_SC, 0, false);
                else *(unsigned*)(y + base + (size_t)(t0 + t) * D) = pk2(h0 * bflo(gw[t]), h1 * bfhi(gw[t])); } }
    }
}

__device__ __forceinline__ float half_max_fast(float v) {
    v = fmaxf(v, dppf<0xB1>(v)); v = fmaxf(v, dppf<0x4E>(v)); v = fmaxf(v, dppf<0x141>(v)); v = fmaxf(v, dppf<0x140>(v));
    { auto r = __builtin_amdgcn_permlane16_swap(__float_as_uint(v), __float_as_uint(v), false, false); v = fmaxf(__uint_as_float(r[0]), __uint_as_float(r[1])); }
    return v;
}
__device__ __forceinline__ void ln1_router_mfma_phase(LAS unsigned char* lds, const bf16_t* z, const float* g1, const float* b1, const float* wrt, const float* brt,
                                                      float* stats, unsigned char* x1f8, float* tokg, unsigned* gcnt, int* row_tok, int* pos_out, int G) {
    const int tid = opaque_tid(), lane = tid & 63, wave = __builtin_amdgcn_readfirstlane(tid >> 6);
    constexpr int RS = 2064;
    LAS unsigned char* XH = lds; LAS unsigned char* XL = lds + 16 * RS; LAS float* PART = (LAS float*)(lds + 32 * RS);
    LAS int* hist = (LAS int*)(lds + MISC_HIST);
    LAS int* tokl = (LAS int*)(lds + 32 * RS + 16896); LAS int* sBase = tokl + 512; LAS int* wcnt = sBase + 32;
    bf16x8 Bh[4][2], Bl[4][2];
    { const int n = lane & 15, kg = lane >> 4;
#pragma unroll
      for (int c = 0; c < 4; ++c)
#pragma unroll
          for (int h = 0; h < 2; ++h) { float wv[8];
#pragma unroll
              for (int j = 0; j < 8; ++j) wv[j] = wrt[(size_t)(128 * wave + 32 * c + 8 * kg + j) * NE + 16 * h + n];
#pragma unroll
              for (int j = 0; j < 8; ++j) { const unsigned hb = f2bf(wv[j]); Bh[c][h][j] = (short)hb; Bl[c][h][j] = (short)f2bf(wv[j] - __uint_as_float(hb << 16)); } } }
    f32x4 gv[4], bv[4];
#pragma unroll
    for (int i = 0; i < 4; ++i) { gv[i] = *(const f32x4*)(g1 + 4 * lane + 256 * i); bv[i] = *(const f32x4*)(b1 + 4 * lane + 256 * i); }
    const float bias_e = brt[lane & 31];
    for (int tile = blockIdx.x; tile < T / 128; tile += G) {
        if (tid < 32) hist[tid] = 0;
        __syncthreads();
        const int rb = tile * 128 + 2 * wave;
        u32x2 nv[2][4];
#pragma unroll
        for (int q = 0; q < 2; ++q)
#pragma unroll
            for (int i = 0; i < 4; ++i) nv[q][i] = *(const u32x2*)(z + (size_t)(rb + q) * D + 4 * lane + 256 * i);
        for (int st = 0; st < 8; ++st) {
            f32x4 v[2][4];
#pragma unroll
            for (int q = 0; q < 2; ++q)
#pragma unroll
                for (int i = 0; i < 4; ++i) v[q][i] = (f32x4){bflo(nv[q][i].x), bfhi(nv[q][i].x), bflo(nv[q][i].y), bfhi(nv[q][i].y)};
            { const int sn = (st < 7 ? st + 1 : st);
#pragma unroll
              for (int q = 0; q < 2; ++q)
#pragma unroll
                  for (int i = 0; i < 4; ++i) nv[q][i] = *(const u32x2*)(z + (size_t)(rb + 16 * sn + q) * D + 4 * lane + 256 * i); }
#pragma unroll
            for (int q = 0; q < 2; ++q) { const int row = rb + 16 * st + q; float s = 0.f;
#pragma unroll
                for (int i = 0; i < 4; ++i) s += (v[q][i][0] + v[q][i][1]) + (v[q][i][2] + v[q][i][3]);
                const float mean = wave_sum_fast(s) * (1.0f / D); float qq = 0.f;
#pragma unroll
                for (int i = 0; i < 4; ++i) { v[q][i] = v[q][i] - mean; qq += (v[q][i][0] * v[q][i][0] + v[q][i][1] * v[q][i][1]) + (v[q][i][2] * v[q][i][2] + v[q][i][3] * v[q][i][3]); }
                const float rstd = 1.0f / sqrtf(wave_sum_fast(qq) * (1.0f / D) + LN_EPS);
                if (lane == 0) *(f32x2*)(stats + (size_t)row * 2) = (f32x2){mean, rstd};
                LAS unsigned char* xh = XH + (2 * wave + q) * RS + 8 * lane; LAS unsigned char* xl = XL + (2 * wave + q) * RS + 8 * lane;
#pragma unroll
                for (int i = 0; i < 4; ++i) { v[q][i] = v[q][i] * rstd * gv[i] + bv[i];
                    *(unsigned*)(x1f8 + (size_t)row * D + 4 * lane + 256 * i) = pk4_fp8(v[q][i][0], v[q][i][1], v[q][i][2], v[q][i][3]);
                    u32x2 hw; hw.x = cvt_pk_bf16(v[q][i][0], v[q][i][1]); hw.y = cvt_pk_bf16(v[q][i][2], v[q][i][3]);
                    u32x2 lw; lw.x = cvt_pk_bf16(v[q][i][0] - __uint_as_float(hw.x << 16), v[q][i][1] - __uint_as_float(hw.x & 0xffff0000u));
                    lw.y = cvt_pk_bf16(v[q][i][2] - __uint_as_float(hw.y << 16), v[q][i][3] - __uint_as_float(hw.y & 0xffff0000u));
                    *(LAS u32x2*)(xh + 512 * i) = hw; *(LAS u32x2*)(xl + 512 * i) = lw; } }
            __syncthreads();
            f32x4 acc[2] = {(f32x4){0.f, 0.f, 0.f, 0.f}, (f32x4){0.f, 0.f, 0.f, 0.f}};
            { const int aoff = (lane & 15) * RS + (128 * wave + 8 * (lane >> 4)) * 2;
#pragma unroll
              for (int c = 0; c < 4; ++c) { const bf16x8 ah = *(const LAS bf16x8*)(XH + aoff + 64 * c), al = *(const LAS bf16x8*)(XL + aoff + 64 * c);
#pragma unroll
                  for (int h = 0; h < 2; ++h) { acc[h] = __builtin_amdgcn_mfma_f32_16x16x32_bf16(ah, Bh[c][h], acc[h], 0, 0, 0);
                      acc[h] = __builtin_amdgcn_mfma_f32_16x16x32_bf16(al, Bh[c][h], acc[h], 0, 0, 0); acc[h] = __builtin_amdgcn_mfma_f32_16x16x32_bf16(ah, Bl[c][h], acc[h], 0, 0, 0); } } }
#pragma unroll
            for (int h = 0; h < 2; ++h)
#pragma unroll
                for (int r = 0; r < 4; ++r) PART[(wave * 16 + 4 * (lane >> 4) + r) * 33 + 16 * h + (lane & 15)] = acc[h][r];
            __syncthreads();
            float lv = bias_e;
#pragma unroll
            for (int w2 = 0; w2 < 8; ++w2) lv += PART[(w2 * 16 + 2 * wave + (lane >> 5)) * 33 + (lane & 31)];
            float tv[4]; int ti[4];
#pragma unroll
            for (int k = 0; k < 4; ++k) { const float m = half_max_fast(lv); const unsigned long long bl = __ballot(lv == m);
                const int i0 = __ffs((int)(unsigned)bl) - 1, i1 = __ffs((int)(unsigned)(bl >> 32)) - 1; const int idx = (lane >> 5) ? i1 : i0;
                tv[k] = m; ti[k] = idx; if ((lane & 31) == idx) lv = -__builtin_inff(); }
            if ((lane & 31) == 0) { const int row = rb + 16 * st + (lane >> 5);
                const float e1 = __expf(tv[1] - tv[0]), e2 = __expf(tv[2] - tv[0]), e3 = __expf(tv[3] - tv[0]); const float inv = 1.0f / (1.0f + e1 + e2 + e3);
                *(LAS v4i_t*)(tokl + (16 * st + 2 * wave + (lane >> 5)) * 4) = (v4i_t){ti[0], ti[1], ti[2], ti[3]};
                *(f32x4*)(tokg + (size_t)row * 4) = (f32x4){inv, e1 * inv, e2 * inv, e3 * inv};
#pragma unroll
                for (int k = 0; k < 4; ++k) __hip_atomic_fetch_add(hist + ti[k], 1, __ATOMIC_RELAXED, __HIP_MEMORY_SCOPE_WORKGROUP); }
        }
        __syncthreads();
        if (tid < 32) sBase[tid] = (int)__hip_atomic_fetch_add(gcnt + tid, (unsigned)hist[tid], __ATOMIC_RELAXED, __HIP_MEMORY_SCOPE_AGENT);
        { const int token = tile * 128 + (tid >> 2), k = tid & 3; const int e = tokl[tid];
          int myrank = 0;
          for (int ee = 0; ee < 32; ++ee) { const unsigned long long m = __ballot(e == ee); if (e == ee) myrank = __popcll(m & ((1ull << lane) - 1ull)); if (lane == 0) wcnt[ee * 8 + wave] = __popcll(m); }
          __syncthreads();
          int wpre = 0;
          for (int w = 0; w < wave; ++w) wpre += wcnt[e * 8 + w];
          const int slot = sBase[e] + wpre + myrank;
          row_tok[e * RT_CAP + slot] = token; pos_out[(size_t)token * 4 + k] = (e << 20) | slot; }
        __syncthreads();
    }
}

__device__ __forceinline__ void build_tfirst(LAS int* tfirst, const unsigned* gcnt) {
    const int tid = opaque_tid();
    if (tid < 64) { const int c = (tid < 32) ? (int)gcnt[tid] : 0; const int tiles = (c + 255) >> 8; int incl = tiles;
#pragma unroll
        for (int off = 1; off < 32; off <<= 1) { const int n = __shfl_up(incl, off); if (tid >= off) incl += n; }
        if (tid < 32) tfirst[tid] = incl - tiles; if (tid == 31) tfirst[32] = incl; }
    __syncthreads();
}
__device__ __forceinline__ int build_tile_e(LAS unsigned char* tile_e, LAS int* tfirst, const unsigned* gcnt) {
    build_tfirst(tfirst, gcnt);
    const int tid = opaque_tid(); const int n_rt = tfirst[32];
    for (int rt = tid; rt < n_rt; rt += 512) { int e = 0; for (int q = 1; q < 32; ++q) e += (rt >= tfirst[q]) ? 1 : 0; tile_e[rt] = (unsigned char)e; }
    __syncthreads();
    return n_rt;
}

__device__ __forceinline__ void combine_ln2_phase(const bf16_t* x1b, const void* ybv, const int* pos_out, const float* tokg, const float* g2, const float* b2, float* outf, bf16_t* outb, unsigned char* outf8, int G,
                                                  const bf16_t* zb, const float* g1, const float* b1, LAS unsigned char* lds, const unsigned* gcnt) {
    const int tid = opaque_tid(), lane = tid & 63, wave = __builtin_amdgcn_readfirstlane(tid >> 6);
    LAS int* tfirst = (LAS int*)lds; build_tfirst(tfirst, gcnt);
    f32x4 gv[4], bv[4], g1v[4], b1v[4];
#pragma unroll
    for (int i = 0; i < 4; ++i) { gv[i] = *(const f32x4*)(g2 + 16 * lane + 4 * i); bv[i] = *(const f32x4*)(b2 + 16 * lane + 4 * i);
        g1v[i] = *(const f32x4*)(g1 + 16 * lane + 4 * i) * ALPHA; b1v[i] = *(const f32x4*)(b1 + 16 * lane + 4 * i) * ALPHA; }
    static_assert(X1_RECOMPUTE && Y_F8, "this combine reads the bf16 z + LayerNorm1 statistics and fp8 expert outputs");
    const unsigned char* yb = (const unsigned char*)ybv;
    const int first = blockIdx.x * 8 + wave, stride = G * 8;
    for (int base = first; base < T; base += stride * 64) {
        int nrow = (T - base + stride - 1) / stride; if (nrow > 64) nrow = 64;
        int4 ps = make_int4(0, 0, 0, 0); f32x4 gt = (f32x4){0.f, 0.f, 0.f, 0.f}; f32x2 st = (f32x2){0.f, 0.f};
        if (lane < nrow) { const size_t rw = (size_t)(base + lane * stride); ps = *(const int4*)(pos_out + rw * 4);
            ps.x = (tfirst[ps.x >> 20] << 8) + (ps.x & 0xFFFFF); ps.y = (tfirst[ps.y >> 20] << 8) + (ps.y & 0xFFFFF); ps.z = (tfirst[ps.z >> 20] << 8) + (ps.z & 0xFFFFF); ps.w = (tfirst[ps.w >> 20] << 8) + (ps.w & 0xFFFFF);
            gt = *(const f32x4*)(tokg + rw * 4); st = *(const f32x2*)((const float*)x1b + rw * 2); }
        u32x4 nz[2], ny[4];
#define CMB_LOAD(i_) do { const int row_ = base + (i_) * stride; \
            const int p0_ = __builtin_amdgcn_readlane(ps.x, (i_)), p1_ = __builtin_amdgcn_readlane(ps.y, (i_)), p2_ = __builtin_amdgcn_readlane(ps.z, (i_)), p3_ = __builtin_amdgcn_readlane(ps.w, (i_)); \
            nz[0] = *(const u32x4*)(zb + (size_t)row_ * D + 16 * lane); nz[1] = *(const u32x4*)(zb + (size_t)row_ * D + 16 * lane + 8); \
            ny[0] = *(const u32x4*)(yb + (size_t)p0_ * D + 16 * lane); ny[1] = *(const u32x4*)(yb + (size_t)p1_ * D + 16 * lane); \
            ny[2] = *(const u32x4*)(yb + (size_t)p2_ * D + 16 * lane); ny[3] = *(const u32x4*)(yb + (size_t)p3_ * D + 16 * lane); } while (0)
        CMB_LOAD(0);
        for (int it = 0; it < nrow; ++it) {
            const int row = base + it * stride;
            const float g0 = __uint_as_float(__builtin_amdgcn_readlane(__float_as_uint(gt[0]), it)), g1_ = __uint_as_float(__builtin_amdgcn_readlane(__float_as_uint(gt[1]), it)),
                        g2_ = __uint_as_float(__builtin_amdgcn_readlane(__float_as_uint(gt[2]), it)), g3_ = __uint_as_float(__builtin_amdgcn_readlane(__float_as_uint(gt[3]), it));
            const float gk[4] = {g0 * (1.0f / 16.0f), g1_ * (1.0f / 16.0f), g2_ * (1.0f / 16.0f), g3_ * (1.0f / 16.0f)};
            const float mean1 = __uint_as_float(__builtin_amdgcn_readlane(__float_as_uint(st[0]), it)), rstd1 = __uint_as_float(__builtin_amdgcn_readlane(__float_as_uint(st[1]), it));
            f32x4 v[4]; float s = 0.f;
#pragma unroll
            for (int i = 0; i < 4; ++i) { const unsigned w0 = nz[i >> 1][(i & 1) * 2], w1 = nz[i >> 1][(i & 1) * 2 + 1];
                const f32x4 xin = (f32x4){bflo(w0), bfhi(w0), bflo(w1), bfhi(w1)};
                v[i] = ((xin - mean1) * rstd1) * g1v[i] + b1v[i];
#pragma unroll
                for (int k = 0; k < 4; ++k) { const f32x2 lo = __builtin_amdgcn_cvt_pk_f32_fp8((int)ny[k][i], false), hi = __builtin_amdgcn_cvt_pk_f32_fp8((int)ny[k][i], true);
                    v[i][0] += gk[k] * lo[0]; v[i][1] += gk[k] * lo[1]; v[i][2] += gk[k] * hi[0]; v[i][3] += gk[k] * hi[1]; }
                s += (v[i][0] + v[i][1]) + (v[i][2] + v[i][3]); }
            { const int itn = (it + 1 < nrow) ? it + 1 : it; CMB_LOAD(itn); }
            const float mean = wave_sum_fast(s) * (1.0f / D); float q = 0.f;
#pragma unroll
            for (int i = 0; i < 4; ++i) { v[i] = v[i] - mean; q += (v[i][0] * v[i][0] + v[i][1] * v[i][1]) + (v[i][2] * v[i][2] + v[i][3] * v[i][3]); }
            const float rstd = 1.0f / sqrtf(wave_sum_fast(q) * (1.0f / D) + LN_EPS);
#pragma unroll
            for (int i = 0; i < 4; ++i) v[i] = v[i] * rstd * gv[i] + bv[i];
            if (outf) {
#pragma unroll
                for (int i = 0; i < 4; ++i) *(f32x4*)(outf + (size_t)row * D + 16 * lane + 4 * i) = v[i]; }
            else { u32x4 w0, w1; w0.x = pk2(v[0][0], v[0][1]); w0.y = pk2(v[0][2], v[0][3]); w0.z = pk2(v[1][0], v[1][1]); w0.w = pk2(v[1][2], v[1][3]);
                w1.x = pk2(v[2][0], v[2][1]); w1.y = pk2(v[2][2], v[2][3]); w1.z = pk2(v[3][0], v[3][1]); w1.w = pk2(v[3][2], v[3][3]);
                *(u32x4*)(outb + (size_t)row * D + 16 * lane) = w0; *(u32x4*)(outb + (size_t)row * D + 16 * lane + 8) = w1;
                u32x4 f8; f8.x = pk4_fp8(v[0][0], v[0][1], v[0][2], v[0][3]); f8.y = pk4_fp8(v[1][0], v[1][1], v[1][2], v[1][3]); f8.z = pk4_fp8(v[2][0], v[2][1], v[2][2], v[2][3]); f8.w = pk4_fp8(v[3][0], v[3][1], v[3][2], v[3][3]);
                *(u32x4*)(outf8 + (size_t)row * D + 16 * lane) = f8; }
        }
#undef CMB_LOAD
    }
}

#ifndef PH_MASK
#define PH_MASK 0xFFFFFF
#endif
#ifndef NCONV
#define NCONV 32
#endif
#ifndef DUP_MASK
#define DUP_MASK 0
#endif
#define PH(b) if (PH_MASK & (1u << (b))) for (int rep_ = 0; rep_ < (((DUP_MASK >> (b)) & 1) ? 2 : 1); ++rep_)
#define CAS __attribute__((address_space(4)))
__device__ __forceinline__ const float* arg_ptr(int k) {
    const CAS char* kp = (const CAS char*)__builtin_amdgcn_kernarg_segment_ptr();
    asm volatile("" : "+s"(kp));
    return *(const float* const CAS*)(kp + 8 * k);
}
#define AIN(k) arg_ptr(k)
#define WSP() ((unsigned char*)arg_ptr(23))
#define OUTP() ((float*)arg_ptr(22))

__device__ __forceinline__ int opaque_s(int v) { asm volatile("" : "+s"(v)); return v; }
__device__ __forceinline__ LAS unsigned char* opaque_lds(LAS unsigned char* p) { unsigned v = (unsigned)(size_t)p; asm volatile("" : "+s"(v)); return (LAS unsigned char*)(size_t)v; }
#define PHASE_ENV unsigned char* ws = WSP(); LAS unsigned char* ldsp = opaque_lds((LAS unsigned char*)lds_raw); const int Gp = opaque_s((int)gridDim.x); const int cp = opaque_s((int)blockIdx.x); (void)ws; (void)ldsp; (void)Gp; (void)cp
#define GCNT(ws_, layer_) ((unsigned*)((ws_) + WS_CTL) + 9216 + 64 * (layer_))
#define GRID_BAR() do { XcdBarrier b_; b_.bar = (unsigned*)(WSP() + WS_CTL); b_.x = xb_xcc_id(); b_.st = (volatile LAS unsigned*)(opaque_lds((LAS unsigned char*)lds_raw) + MISC_OFF); xcd_barrier(b_); } while (0)

__global__ void __launch_bounds__(512, 2) fwd_kernel(Args a) {
    extern __shared__ __attribute__((aligned(16))) unsigned char lds_raw[];
    __builtin_amdgcn_s_setreg(1 | (23 << 6), 1);
    { LAS unsigned char* lds0 = (LAS unsigned char*)lds_raw; const int tid0 = threadIdx.x;
      for (int u = tid0; u < (LDS_BYTES - MISC_OFF) / 4; u += 512) ((LAS unsigned*)(lds0 + MISC_OFF))[u] = 0u;
      __syncthreads();
      (void)xcd_barrier_post((unsigned*)(WSP() + WS_CTL), (volatile LAS unsigned*)(lds0 + MISC_OFF)); }

    PH(0) { PHASE_ENV; prologue_phase(ldsp, Gp); }
    GRID_BAR();

    for (int layer = 0; layer < DEPTH; ++layer) {
        const int j = layer >> 1;
        if ((layer & 1) == 0) {
            PH(1) { PHASE_ENV; pg8::TileOrderT<8> S; S.init(T / 256, 8, Gp, cp);
              pg8::SrcDenseT<FP8_IN != 0> X{(const char*)(ws + (FP8_IN ? WS_XF8 : WS_XBF)), (const char*)(ws + WS_WIN) + (size_t)j * 2048 * 1024 * (FP8_IN ? 1 : 2), D, D};
              pg8::EpiIn E{(bf16_t*)(ws + WS_GG), FP8_IN ? (1.0f / 32.0f) : 1.0f};
              pg8::gemm_phase(ldsp, opaque_s(D), S, X, E); }
            GRID_BAR();
            PH(2) { PHASE_ENV; conv_phase((const bf16_t*)(ws + WS_REC), (bf16_t*)(ws + WS_U), AIN(6) + (size_t)j * 4 * D, AIN(7) + (size_t)j * D, Gp); }
            GRID_BAR();
            PH(3) { PHASE_ENV; pg8::TileOrderT<8> S; S.init(T / 256, 8, Gp, cp);
              pg8::SrcGates X{(const char*)(ws + WS_U), (const char*)((bf16_t*)(ws + WS_WGATE) + (size_t)j * 8 * 256 * 128), D};
              pg8::EpiGates E{(bf16_t*)(ws + WS_LA), (bf16_t*)(ws + WS_BB), (const bf16_t*)(ws + WS_U), AIN(9) + (size_t)j * D, AIN(11) + (size_t)j * D, AIN(12) + (size_t)j * D};
              pg8::gemm_phase(ldsp, opaque_s(128), S, X, E); }
            GRID_BAR();
            PH(4) { PHASE_ENV; scan1_phase((const bf16_t*)(ws + WS_LA), (const bf16_t*)(ws + WS_BB), (float*)(ws + WS_AGG), Gp); }
            GRID_BAR();
            PH(4) { PHASE_ENV; scan2_phase((const bf16_t*)(ws + WS_LA), (const bf16_t*)(ws + WS_BB), (const float*)(ws + WS_AGG), (const bf16_t*)(ws + WS_GG), (bf16_t*)(ws + WS_YMIX), Gp); }
            GRID_BAR();
        } else {
            PH(5) { PHASE_ENV; pg8::TileOrderT<12> S; S.init(T / 256, 12, Gp, cp);
              pg8::SrcDenseT<FP8_QKV != 0> X{(const char*)(ws + (FP8_QKV ? WS_XF8 : WS_XBF)), (const char*)(ws + WS_WQKV) + (size_t)j * 3072 * 1024 * (FP8_QKV ? 1 : 2), D, D};
              pg8::EpiQKV E{};
              pg8::gemm_phase(ldsp, opaque_s(D), S, X, E); }
            GRID_BAR();
            PH(7) { PHASE_ENV;
              const moba::Bases BP{(const bf16_t*)(ws + WS_Q), (const bf16_t*)(ws + WS_K), (const bf16_t*)(ws + WS_V), (bf16_t*)(ws + WS_YMIX), (const float*)(ws + WS_KMH)};
              moba::attn_phase((char*)lds_raw, BP, Gp, cp); }
            GRID_BAR();
        }
        PH(8) { PHASE_ENV; pg8::TileOrderT<4> S; S.init(T / 256, 4, Gp, cp);
          pg8::SrcDenseT<FP8_OUT != 0> X{(const char*)(ws + WS_YMIX), (const char*)(ws + WS_WOUT) + (size_t)layer * 1024 * 1024 * (FP8_OUT ? 1 : 2), D, D};
          pg8::EpiOut E{(void*)(ws + WS_Z), (const bf16_t*)(ws + WS_XBF), FP8_OUT ? 1.0f / (32.0f * YMIX_SC) : 1.0f};
          pg8::gemm_phase(ldsp, FP8_OUT ? opaque_s(D) : D, S, X, E); }
        GRID_BAR();
        PH(9) { PHASE_ENV;
          ln1_router_mfma_phase(ldsp, (const bf16_t*)(ws + WS_Z), AIN(1) + (size_t)layer * D, AIN(2) + (size_t)layer * D, AIN(16) + (size_t)layer * D * NE, AIN(17) + (size_t)layer * NE,
                                (float*)(ws + WS_X1BF), (unsigned char*)(ws + WS_X1F8), (float*)(ws + WS_TOKG), GCNT(ws, layer), (int*)(ws + WS_ROWTOK), (int*)(ws + WS_POS), Gp); }
        GRID_BAR();
        const int nconv = (layer + 1 < DEPTH) ? NCONV : 0;
        PH(11) { PHASE_ENV; const int Gg = Gp - opaque_s(nconv);
          if (cp >= Gg) cv_moe_range(ws, ldsp, layer + 1, 0, 32 * 512, Gp - Gg, cp - Gg);
          else { LAS unsigned char* tile_e = ldsp + MISC_TILE_E; const int n_rt = build_tile_e(tile_e, (LAS int*)(ldsp + MISC_TF), GCNT(ws, layer));
          pg8::TileOrderT<8> S; S.init(n_rt, 8, Gg, cp);
          pg8::SrcMoeGather<FP8_GU != 0> X{(const char*)(ws + (FP8_GU ? WS_X1F8 : WS_X1BF)), (const char*)(ws + WS_WGU) + (size_t)layer * NE * 2048 * 1024 * (FP8_GU ? 1 : 2), (const int*)(ws + WS_ROWTOK), tile_e, D, 8, (LAS int*)(ldsp + MISC_TAB), (const LAS int*)(ldsp + MISC_TF)};
          pg8::EpiGU<FP8_GU != 0, FP8_DN != 0> E{(void*)(ws + WS_HBUF), AIN(19) + (size_t)layer * NE * 2048, tile_e, (LAS float*)(ldsp + MISC_BIAS)};
          pg8::gemm_phase(ldsp, opaque_s(D), S, X, E); } }
        GRID_BAR();
        PH(12) { PHASE_ENV; const int Gg = Gp - opaque_s(nconv);
          if (cp >= Gg) cv_moe_range(ws, ldsp, layer + 1, 32 * 512, CV_MOE, Gp - Gg, cp - Gg);
          else { LAS unsigned char* tile_e = ldsp + MISC_TILE_E; const int n_rt = build_tile_e(tile_e, (LAS int*)(ldsp + MISC_TF), GCNT(ws, layer));
          pg8::TileOrderT<4> S; S.init(n_rt, 4, Gg, cp);
          pg8::SrcMoeDense<FP8_DN != 0> X{(const char*)(ws + WS_HBUF), (const char*)(ws + WS_WDN) + (size_t)layer * NE * 1024 * 1024 * (FP8_DN ? 1 : 2), tile_e, D, 4};
          pg8::EpiDown<FP8_DN != 0> E{(void*)(ws + WS_YBUF), AIN(21) + (size_t)layer * NE * D, tile_e, (LAS float*)(ldsp + MISC_BIAS)};
          pg8::gemm_phase(ldsp, opaque_s(D), S, X, E); } }
        GRID_BAR();
        PH(13) { PHASE_ENV;
          if ((layer & 1) == 0) { float* ksz = (float*)(ws + WS_KMH); for (int i = cp * 512 + opaque_tid(); i < 128 * 1024; i += Gp * 512) ksz[i] = 0.f; }
          combine_ln2_phase((const bf16_t*)(ws + WS_X1BF), (const void*)(ws + WS_YBUF), (const int*)(ws + WS_POS), (const float*)(ws + WS_TOKG), AIN(3) + (size_t)layer * D, AIN(4) + (size_t)layer * D,
                            (layer == DEPTH - 1) ? OUTP() : (float*)nullptr, (bf16_t*)(ws + WS_XBF), (unsigned char*)(ws + WS_XF8), Gp, (const bf16_t*)(ws + WS_Z), AIN(1) + (size_t)layer * D, AIN(2) + (size_t)layer * D, ldsp, GCNT(ws, layer)); }
        if (layer != DEPTH - 1) GRID_BAR();
    }
}

extern "C" void kernel_launch(void* const* d_in, const int* in_sizes, int n_in, void* d_out, int out_size, void* d_ws, size_t ws_size, hipStream_t stream) {
    static int grid = 0;
    if (grid == 0) {
        if (n_in != 22 || in_sizes[0] != T * D || out_size != T * D || ws_size < WS_END) { fprintf(stderr, "kernel_launch: unexpected shapes (n_in %d, in0 %d, out %d, ws %zu)\n", n_in, n_in > 0 ? in_sizes[0] : -1, out_size, ws_size); grid = -1; return; }
        int dev = 0, cus = 0, per_cu = 0;
        if (hipGetDevice(&dev) != hipSuccess || hipDeviceGetAttribute(&cus, hipDeviceAttributeMultiprocessorCount, dev) != hipSuccess) { grid = -1; return; }
        if (hipFuncSetAttribute((const void*)fwd_kernel, hipFuncAttributeMaxDynamicSharedMemorySize, LDS_BYTES) != hipSuccess) { fprintf(stderr, "kernel_launch: hipFuncSetAttribute failed\n"); grid = -1; return; }
        if (hipOccupancyMaxActiveBlocksPerMultiprocessor(&per_cu, (const void*)fwd_kernel, 512, LDS_BYTES) != hipSuccess || per_cu < 1) fprintf(stderr, "kernel_launch: occupancy query says %d\n", per_cu);
        (void)hipGetLastError();
        grid = cus;
    }
    if (grid < 0) return;
    if (hipMemsetAsync((char*)d_ws + WS_CTL, 0, CTL_ZERO_BYTES, stream) != hipSuccess) return;
    Args a{};
    for (int i = 0; i < 22; ++i) a.in[i] = (const float*)d_in[i];
    a.out = (float*)d_out; a.ws = (unsigned char*)d_ws;
    hipLaunchKernelGGL(fwd_kernel, dim3(grid), dim3(512), LDS_BYTES, stream, a);
}
```

```cpp
#include <hip/hip_runtime.h>
#include <cstdio>
#include <cstdint>

#define LAS __attribute__((address_space(3)))
#ifndef FP8_X
#define FP8_X 1
#endif
#ifndef FP8_IN
#define FP8_IN 1
#endif
#ifndef FP8_QKV
#define FP8_QKV FP8_X
#endif
#ifndef FP8_OUT
#define FP8_OUT 1
#endif
#define YMIX_SC 8.0f
#ifndef H_BLOCKED
#define H_BLOCKED 1
#endif
#ifndef FP8_SCAN
#define FP8_SCAN 1
#endif
#define SCAN_SC 16.0f
#ifndef X1_RECOMPUTE
#define X1_RECOMPUTE (!Z_F32 && FP8_GU)
#endif
#ifndef Z_F32
#define Z_F32 0
#endif
#ifndef Y_F8
#define Y_F8 1
#endif
#ifndef FP8_GU
#define FP8_GU 1
#endif
#ifndef FP8_DN
#define FP8_DN 1
#endif
typedef unsigned short bf16_t;
typedef short bf16x8 __attribute__((ext_vector_type(8)));
typedef short s16x4 __attribute__((ext_vector_type(4)));
typedef float f32x2 __attribute__((ext_vector_type(2)));
typedef float f32x4 __attribute__((ext_vector_type(4)));
typedef float f32x16 __attribute__((ext_vector_type(16)));
typedef unsigned u32x2 __attribute__((ext_vector_type(2)));
typedef unsigned u32x4 __attribute__((ext_vector_type(4)));
typedef int v4i_t __attribute__((ext_vector_type(4)));
typedef int v8i_t __attribute__((ext_vector_type(8)));

constexpr int T = 32768, D = 1024, SEQ = 4096, NE = 32, DEPTH = 4;
constexpr float ALPHA = 1.681792830507429f;
constexpr float LN_EPS = 1e-5f;
constexpr int P_ROWS = 139264;

constexpr size_t MiB = 1u << 20;
constexpr size_t WS_CTL = 0, CTL_ZERO_BYTES = 64 * 1024;
constexpr size_t WS_KMH = 4 * MiB;
constexpr size_t WS_TOKG = 6 * MiB, WS_POS = 7 * MiB, WS_ROWTOK = 8 * MiB;
constexpr size_t WS_WIN = 16 * MiB;
constexpr size_t WS_WGATE = 24 * MiB;
constexpr size_t WS_WOUT = 32 * MiB;
constexpr size_t WS_WQKV = 40 * MiB;
constexpr size_t WS_WGU = 64 * MiB;
constexpr size_t WS_WDN = 576 * MiB;
constexpr size_t WS_XBF = 832 * MiB, WS_X1BF = 896 * MiB;
constexpr size_t WS_Z = 960 * MiB;
constexpr size_t WS_AGG = 1088 * MiB;
constexpr size_t WS_XF8 = 1140 * MiB;
constexpr size_t WS_X1F8 = 1100 * MiB;
constexpr size_t WS_YMIX = 1344 * MiB;
constexpr size_t WS_GG = 1408 * MiB, WS_REC = 1472 * MiB, WS_U = 1536 * MiB, WS_LA = 1600 * MiB, WS_BB = 1728 * MiB;
constexpr size_t WS_Q = 1408 * MiB, WS_K = 1472 * MiB, WS_V = 1536 * MiB;
static_assert(WS_K - WS_Q == 64 * MiB && WS_V - WS_K == 64 * MiB && WS_REC - WS_GG == 64 * MiB, "epilogue strides");
constexpr size_t WS_HBUF = 1856 * MiB, WS_YBUF = 2128 * MiB, WS_END = 2400 * MiB;

constexpr int LDS_SCRATCH = 135168;
constexpr int CV_SCR = 17024;
constexpr int MISC_OFF = 8 * CV_SCR;
constexpr int MISC_HIST = MISC_OFF + 64, MISC_TILE_E = MISC_OFF + 256, MISC_TAB = MISC_OFF + 1280;
constexpr int LDS_BYTES = MISC_OFF + 5120;
constexpr int RT_CAP = 32768;
constexpr int MISC_TF = MISC_OFF + 4352;
constexpr int MISC_BIAS = MISC_TAB + 1024;

#define LDS_WAIT() asm volatile("s_waitcnt lgkmcnt(0)" ::: "memory")
#define VM_WAIT() asm volatile("s_waitcnt vmcnt(0)" ::: "memory")

__device__ __forceinline__ unsigned f2bf(float f) { unsigned u = __float_as_uint(f); return (u + 0x7fffu + ((u >> 16) & 1u)) >> 16; }
__device__ __forceinline__ unsigned pk2(float lo, float hi) { return f2bf(lo) | (f2bf(hi) << 16); }
__device__ __forceinline__ float bflo(unsigned w) { return __uint_as_float(w << 16); }
__device__ __forceinline__ float bfhi(unsigned w) { return __uint_as_float(w & 0xffff0000u); }
__device__ __forceinline__ unsigned cvt_pk_bf16(float lo, float hi) { unsigned r; asm volatile("v_cvt_pk_bf16_f32 %0, %1, %2" : "=v"(r) : "v"(lo), "v"(hi)); return r; }
__device__ __forceinline__ unsigned pk4_fp8(float a, float b, float c, float d) { int w = 0; w = __builtin_amdgcn_cvt_pk_fp8_f32(a, b, w, false); w = __builtin_amdgcn_cvt_pk_fp8_f32(c, d, w, true); return (unsigned)w; }
__device__ __forceinline__ int opaque_tid() { int t = threadIdx.x; asm volatile("" : "+v"(t)); return t; }
template <int CTRL> __device__ __forceinline__ float dppf(float v) { return __uint_as_float(__builtin_amdgcn_update_dpp(0u, __float_as_uint(v), CTRL, 0xf, 0xf, true)); }
__device__ __forceinline__ float wave_sum_fast(float v) {
    v += dppf<0xB1>(v); v += dppf<0x4E>(v); v += dppf<0x141>(v); v += dppf<0x140>(v);
    { auto r = __builtin_amdgcn_permlane16_swap(__float_as_uint(v), __float_as_uint(v), false, false); v = __uint_as_float(r[0]) + __uint_as_float(r[1]); }
    { auto r = __builtin_amdgcn_permlane32_swap(__float_as_uint(v), __float_as_uint(v), false, false); v = __uint_as_float(r[0]) + __uint_as_float(r[1]); }
    return v;
}
__device__ __forceinline__ float wave_max_fast(float v) {
    v = fmaxf(v, dppf<0xB1>(v)); v = fmaxf(v, dppf<0x4E>(v)); v = fmaxf(v, dppf<0x141>(v)); v = fmaxf(v, dppf<0x140>(v));
    { auto r = __builtin_amdgcn_permlane16_swap(__float_as_uint(v), __float_as_uint(v), false, false); v = fmaxf(__uint_as_float(r[0]), __uint_as_float(r[1])); }
    { auto r = __builtin_amdgcn_permlane32_swap(__float_as_uint(v), __float_as_uint(v), false, false); v = fmaxf(__uint_as_float(r[0]), __uint_as_float(r[1])); }
    return v;
}
__device__ __forceinline__ float xr_pair(float a, float b) { auto r = __builtin_amdgcn_permlane32_swap(__float_as_uint(a), __float_as_uint(b), false, false); return __uint_as_float(r[0]) + __uint_as_float(r[1]); }
__device__ __forceinline__ float xreduce16(const float (&t16)[16], int lane) {
    float t8[8], t4[4], t2[2], lv;
#pragma unroll
    for (int j = 0; j < 8; ++j) { auto r = __builtin_amdgcn_permlane16_swap(__float_as_uint(t16[j]), __float_as_uint(t16[8 + j]), false, false); t8[j] = __uint_as_float(r[0]) + __uint_as_float(r[1]); }
    { const bool bt = (lane & 8) != 0;
#pragma unroll
      for (int j = 0; j < 4; ++j) { const float send = bt ? t8[j] : t8[4 + j]; t4[j] = (bt ? t8[4 + j] : t8[j]) + dppf<0x128>(send); } }
    { const bool bt = (lane & 4) != 0;
#pragma unroll
      for (int j = 0; j < 2; ++j) { const float send = bt ? t4[j] : t4[2 + j]; t2[j] = (bt ? t4[2 + j] : t4[j]) + dppf<0x1B>(dppf<0x141>(send)); } }
    { const bool bt = (lane & 2) != 0; const float send = bt ? t2[0] : t2[1]; lv = (bt ? t2[1] : t2[0]) + dppf<0x4E>(send); }
    lv += dppf<0xB1>(lv);
    return lv;
}
__device__ __forceinline__ float wave_sum(float v) {
#pragma unroll
    for (int o = 1; o < 64; o <<= 1) v += __shfl_xor(v, o);
    return v;
}

#define XB_TMO      128
#define XB_XCNT(j)  (256  + 64 * (j))
#define XB_XSUB(j)  (1280 + 64 * (j))
#define XB_XGEN(j)  (2304 + 64 * (j))
#define XB_TOP      3328
#define XB_TOPGEN   3392
#define XCD_BAR_WORDS 3456
#define XB_SPIN_CAP (1u << 21)

__device__ __forceinline__ unsigned xb_ld(unsigned* p)              { return __hip_atomic_load(p, __ATOMIC_RELAXED, __HIP_MEMORY_SCOPE_AGENT); }
__device__ __forceinline__ unsigned xb_add(unsigned* p, unsigned v) { return __hip_atomic_fetch_add(p, v, __ATOMIC_RELAXED, __HIP_MEMORY_SCOPE_AGENT); }
__device__ __forceinline__ unsigned xb_xcc_id() { return (unsigned)__builtin_amdgcn_s_getreg((3 << 11) | 20) & 0xFu; }
#define XB_SPIN(cond, bar) do { unsigned _sp = 0; while (cond) { __builtin_amdgcn_s_sleep(1); \
    if ((++_sp & 255u) == 0u) { if (xb_ld(&(bar)[XB_TMO])) break; if (_sp > XB_SPIN_CAP) { atomicAdd(&(bar)[XB_TMO], 1u); break; } } } } while (0)

struct XcdBarrier { unsigned* bar; unsigned x; volatile LAS unsigned* st; };

__device__ __forceinline__ XcdBarrier xcd_barrier_post(unsigned* bar, volatile LAS unsigned* st) {
    XcdBarrier b; b.bar = bar; b.x = xb_xcc_id(); b.st = st;
    if (threadIdx.x == 0) (void)xb_add(&bar[XB_XCNT(b.x)], 1u);
    return b;
}
__device__ __forceinline__ void xcd_barrier_complete(unsigned* bar, unsigned x, unsigned& nloc, unsigned& nx) {
    const unsigned G = gridDim.x * gridDim.y * gridDim.z;
    unsigned sum, cnt, mine, sp = 0u;
    for (;;) {
        sum = 0u; cnt = 0u; mine = 0u;
#pragma unroll
        for (unsigned j = 0; j < 16; ++j) { const unsigned c = xb_ld(&bar[XB_XCNT(j)]); sum += c; cnt += (c > 0u) ? 1u : 0u; mine = (j == x) ? c : mine; }
        if (sum == G) break;
        __builtin_amdgcn_s_sleep(1);
        if ((++sp & 255u) == 0u) { if (xb_ld(&bar[XB_TMO])) break; if (sp > XB_SPIN_CAP) { atomicAdd(&bar[XB_TMO], 1u); break; } }
    }
    nloc = mine > 0u ? mine : 1u; nx = cnt > 0u ? cnt : 1u;
}
__device__ __forceinline__ void xcd_barrier(const XcdBarrier& b) {
    asm volatile("s_waitcnt vmcnt(0)" ::: "memory");
    __syncthreads();
    if (threadIdx.x == 0) {
        unsigned* bar = b.bar;
        __builtin_amdgcn_s_waitcnt(0);
        unsigned nloc = b.st[0], nx = b.st[1];
        if (nloc == 0u) { xcd_barrier_complete(bar, b.x, nloc, nx); b.st[0] = nloc; b.st[1] = nx; }
        const unsigned old = xb_add(&bar[XB_XSUB(b.x)], 1u);
        const unsigned gen = old / nloc;
        if (old + 1u == (gen + 1u) * nloc) {
            __builtin_amdgcn_fence(__ATOMIC_RELEASE, "agent");
            asm volatile("s_waitcnt vmcnt(0)" ::: "memory");
            const unsigned og = xb_add(&bar[XB_TOP], 1u);
            const unsigned tg = og / nx;
            if (og + 1u == (tg + 1u) * nx) xb_add(&bar[XB_TOPGEN], 1u);
            else XB_SPIN(xb_ld(&bar[XB_TOPGEN]) == tg, bar);
            __builtin_amdgcn_fence(__ATOMIC_ACQUIRE, "agent");
            xb_add(&bar[XB_XGEN(b.x)], 1u);
            asm volatile("s_waitcnt vmcnt(0)" ::: "memory");
        } else {
            XB_SPIN(xb_ld(&bar[XB_XGEN(b.x)]) == gen, bar);
            __builtin_amdgcn_fence(__ATOMIC_ACQUIRE, "agent");
            asm volatile("s_waitcnt vmcnt(0)" ::: "memory");
        }
    }
    __syncthreads();
}

__device__ __forceinline__ const float* arg_ptr(int k);
namespace pg8 {
constexpr int BM = 256, BK = 64, HALF = 128, HTB = HALF * BK * 2, STAGE_BYTES = 8 * HTB, NXCD = 8, WGM = 8;
__host__ __device__ __forceinline__ int lds_byte(int r, int c) { const int st = (r >> 4) * 2 + (c >> 5), rr = r & 15, cc = c & 31, ob = rr * 64 + cc * 2; return st * 1024 + (ob ^ (((ob >> 9) & 1) << 5)); }
__host__ __device__ __forceinline__ void stage_rc(int b, int& R, int& C) { const int st = b / 1024, sb = b % 1024, swz = sb ^ (((sb >> 9) & 1) << 5); R = (st >> 1) * 16 + swz / 64; C = (st & 1) * 32 + (swz % 64) / 2; }
__host__ __device__ __forceinline__ int perm32(int rho) { const int n = rho >> 4, i = rho & 15; return 8 * (i >> 2) + 4 * n + (i & 3); }
struct Unit { int pm, pn; };
template <int NN> struct TileOrderT {
    int nM, nwg, G, c;
    static constexpr int nN = NN;
    __device__ void init(int nM_, int, int G_, int c_) { nM = nM_; nwg = nM * NN; G = G_; c = c_; }
    __device__ bool spare() const { const int rounds = (nwg + G - 1) / G, mine = (nwg - c + G - 1) / G; return mine < rounds; }
    __device__ bool next(int i, Unit& u) const {
        const int L = i * G + c; if (L >= nwg) return false;
        int wgid = L; { const int q = nwg >> 3, r = nwg & 7, xcd = wgid & 7, off = wgid >> 3; wgid = (xcd < r ? xcd * (q + 1) : r * (q + 1) + (xcd - r) * q) + off; }
        constexpr int nig = WGM * NN; const int gid = wgid / nig, fm = gid * WGM, w = wgid - gid * nig, gsz = (nM - fm) < WGM ? (nM - fm) : WGM;
        if (gsz == WGM) { u.pm = fm + (w & (WGM - 1)); u.pn = w >> 3; } else { u.pm = fm + (w % gsz); u.pn = w / gsz; }
        return true;
    }
};
template <bool F8_> struct SrcDenseT {
    static constexpr bool GATHER = false, FP8 = F8_, BLK = false; static constexpr int ES = F8_ ? 1 : 2;
    const char* A; const char* Bt; int lda; int K;
    __device__ __forceinline__ unsigned a_base(const Unit& u) const { return (unsigned)u.pm * 256u * lda * ES; }
    __device__ __forceinline__ void a_offs(const Unit&, const int (&)[2], const int (&)[2], unsigned (&)[2][2]) const {}
    __device__ __forceinline__ void idx_prefetch(const Unit&, int, int) const {}
    __device__ __forceinline__ void a_offs_lds(const int (&)[2], const int (&)[2], unsigned (&)[2][2]) const {}
    __device__ __forceinline__ unsigned b_base(const Unit& u) const { return (unsigned)u.pn * 256u * K * ES; }
};
typedef SrcDenseT<false> SrcDense;
struct SrcGates {
    static constexpr bool GATHER = false, FP8 = false, BLK = false;
    const char* A; const char* Bt; int lda;
    __device__ __forceinline__ unsigned a_base(const Unit& u) const { return ((unsigned)u.pm * 256u * lda + (unsigned)u.pn * 128u) * 2u; }
    __device__ __forceinline__ void a_offs(const Unit&, const int (&)[2], const int (&)[2], unsigned (&)[2][2]) const {}
    __device__ __forceinline__ void idx_prefetch(const Unit&, int, int) const {}
    __device__ __forceinline__ void a_offs_lds(const int (&)[2], const int (&)[2], unsigned (&)[2][2]) const {}
    __device__ __forceinline__ unsigned b_base(const Unit& u) const { return (unsigned)u.pn * 256u * 128u * 2u; }
};
template <bool F8_> struct SrcMoeGather {
    static constexpr bool GATHER = true, FP8 = F8_, BLK = false; static constexpr int ES = F8_ ? 1 : 2;
    const char* A; const char* Bt; const int* row_tok; const LAS unsigned char* tile_e; int lda; int nN; LAS int* idx; const LAS int* tfirst;
    __device__ __forceinline__ int rbase(const Unit& u) const { const int e = __builtin_amdgcn_readfirstlane((int)tile_e[u.pm]); return e * RT_CAP + (u.pm - __builtin_amdgcn_readfirstlane(tfirst[e])) * 256; }
    __device__ __forceinline__ unsigned a_base(const Unit&) const { return 0u; }
    __device__ __forceinline__ void a_offs(const Unit& u, const int (&RA)[2], const int (&CA)[2], unsigned (&ao)[2][2]) const {
        int tk[2][2];
#pragma unroll
        for (int h = 0; h < 2; ++h)
#pragma unroll
            for (int i = 0; i < 2; ++i) tk[h][i] = row_tok[rbase(u) + 128 * h + RA[i]];
#pragma unroll
        for (int h = 0; h < 2; ++h)
#pragma unroll
            for (int i = 0; i < 2; ++i) { ao[h][i] = (unsigned)(tk[h][i] * lda * ES + CA[i] * 2); asm volatile("" : "+v"(ao[h][i])); }
    }
    __device__ __forceinline__ void idx_prefetch(const Unit& u, int wid, int lane) const {
        if (wid < 4) __builtin_amdgcn_global_load_lds((const unsigned*)(row_tok + rbase(u) + wid * 64 + lane), (LAS unsigned*)(idx + wid * 64), 4, 0, 0);
    }
    __device__ __forceinline__ void a_offs_lds(const int (&RA)[2], const int (&CA)[2], unsigned (&ao)[2][2]) const {
#pragma unroll
        for (int h = 0; h < 2; ++h)
#pragma unroll
            for (int i = 0; i < 2; ++i) ao[h][i] = (unsigned)(idx[128 * h + RA[i]] * lda * ES + CA[i] * 2);
    }
    __device__ __forceinline__ unsigned b_base(const Unit& u) const { const int e = __builtin_amdgcn_readfirstlane((int)tile_e[u.pm]); return ((unsigned)e * nN + u.pn) * 256u * lda * ES; }
};
template <bool F8_> struct SrcMoeDense {
    static constexpr bool GATHER = false, FP8 = F8_, BLK = F8_ && H_BLOCKED; static constexpr int ES = F8_ ? 1 : 2;
    const char* A; const char* Bt; const LAS unsigned char* tile_e; int lda; int nN;
    __device__ __forceinline__ unsigned a_base(const Unit& u) const { return (unsigned)u.pm * 256u * lda * ES; }
    __device__ __forceinline__ void a_offs(const Unit&, const int (&)[2], const int (&)[2], unsigned (&)[2][2]) const {}
    __device__ __forceinline__ void idx_prefetch(const Unit&, int, int) const {}
    __device__ __forceinline__ void a_offs_lds(const int (&)[2], const int (&)[2], unsigned (&)[2][2]) const {}
    __device__ __forceinline__ unsigned b_base(const Unit& u) const { const int e = __builtin_amdgcn_readfirstlane((int)tile_e[u.pm]); return ((unsigned)e * nN + u.pn) * 256u * lda * ES; }
};

template <class Epi, class Src, class Ord>
__device__ __forceinline__ void gemm_phase(LAS unsigned char* lds, const int K, const Ord& S, const Src& X, const Epi& E) {
    const int tid = opaque_tid(), wid = __builtin_amdgcn_readfirstlane(tid >> 6), lane = tid & 63, wr = wid >> 2, wc = wid & 3, fr = lane & 15, fq = lane >> 4;
    constexpr bool F8 = Src::FP8; constexpr int ES = F8 ? 1 : 2;
    const int nt = K * ES / (BK * 2);
    constexpr bool GA = Src::GATHER;
    int RA[2], CA[2]; unsigned voffA[2], voffB[2];
#pragma unroll
    for (int i = 0; i < 2; ++i) { int R, C; stage_rc(tid * 16 + i * 8192, R, C); RA[i] = R; CA[i] = C; const int Rb = Epi::PERM64 ? (((R >> 5) << 6) + (((R >> 2) & 3) << 4) + (((R >> 4) & 1) << 2) + (R & 3)) : Epi::PERM ? ((R & ~31) + perm32(R & 31)) : R;
        voffA[i] = Src::BLK ? (unsigned)(((C * 2) >> 5) * 8192 + R * 32 + ((C * 2) & 31)) : (unsigned)(R * X.lda * ES + C * 2); voffB[i] = (unsigned)(Rb * K * ES + C * 2); }
    const unsigned kstep = (unsigned)(BK * 2);
    const unsigned kstepA = Src::BLK ? 32768u : kstep;
    const unsigned hstep = (Epi::PERM64 ? 8u : (unsigned)HALF) * K * ES;
    const unsigned hstepA = GA ? 0u : Src::BLK ? 4096u : (unsigned)HALF * X.lda * ES;
    const __amdgpu_buffer_rsrc_t rsA = __builtin_amdgcn_make_buffer_rsrc((void*)X.A, 0, 0x7fffffff, 0x00020000), rsB = __builtin_amdgcn_make_buffer_rsrc((void*)X.Bt, 0, 0x7fffffff, 0x00020000);
    const unsigned ldsw = (unsigned)wid * 1024u;
    const int aoff = lds_byte(wr * 64 + fr, fq * 8), boff = lds_byte(wc * 32 + fr, fq * 8);
#define PG8_SA(b, h) (((b) * 2 + (h)) * HTB)
#define PG8_SB(b, h) ((4 + (b) * 2 + (h)) * HTB)
#define PG8_STAGE_R(rs, bufoff, soff, voff) do { _Pragma("unroll") for (int _i = 0; _i < 2; ++_i) \
        __builtin_amdgcn_raw_ptr_buffer_load_lds(rs, (LAS void*)(lds + (bufoff) + ldsw + _i * 8192), 16, (int)(voff)[_i], (int)(soff), 0, 0); } while (0)
#define PG8_STAGE(bufoff, soff, voff) PG8_STAGE_R(rsB, bufoff, soff, voff)
#define PG8_STAGE_A(bufoff, soff, h, g0, g1) do { if constexpr (GA) { unsigned _o[2] = {g0, g1}; PG8_STAGE_R(rsA, bufoff, soff, _o); } else { PG8_STAGE_R(rsA, bufoff, (soff) + ((h) ? hstepA : 0u), voffA); } } while (0)
#define PG8_LDA(dst, b, h) do { _Pragma("unroll") for (int m = 0; m < 4; ++m) _Pragma("unroll") for (int k = 0; k < 2; ++k) dst[m][k] = *(const LAS bf16x8*)(lds + PG8_SA(b, h) + aoff + m * 2048 + k * 1024); } while (0)
#define PG8_LDB(dst, b, h) do { _Pragma("unroll") for (int n = 0; n < 2; ++n) _Pragma("unroll") for (int k = 0; k < 2; ++k) dst[n][k] = *(const LAS bf16x8*)(lds + PG8_SB(b, h) + boff + n * 2048 + k * 1024); } while (0)
#define PG8_CAT(x0, x1) __builtin_shufflevector(__builtin_bit_cast(v4i_t, x0), __builtin_bit_cast(v4i_t, x1), 0, 1, 2, 3, 4, 5, 6, 7)
#define PG8_MMA(ai, bj, At, Bt) do { __builtin_amdgcn_s_setprio(1); \
        if constexpr (F8) { _Pragma("unroll") for (int n = 0; n < 2; ++n) { const v8i_t b8_ = PG8_CAT(Bt[n][0], Bt[n][1]); _Pragma("unroll") for (int m = 0; m < 4; ++m) { const v8i_t a8_ = PG8_CAT(At[m][0], At[m][1]); \
            asm volatile("v_mfma_f32_16x16x128_f8f6f4 %0, %1, %2, %0" : "+v"(acc[ai][bj][m][n]) : "v"(b8_), "v"(a8_)); } } }     \
        else { _Pragma("unroll") for (int m = 0; m < 4; ++m) _Pragma("unroll") for (int n = 0; n < 2; ++n) _Pragma("unroll") for (int k = 0; k < 2; ++k) \
            acc[ai][bj][m][n] = __builtin_amdgcn_mfma_f32_16x16x32_bf16(Bt[n][k], At[m][k], acc[ai][bj][m][n], 0, 0, 0); } \
        __builtin_amdgcn_s_setprio(0); } while (0)
#define PG8_MMA_Z(ai, bj, At, Bt) do { if constexpr (F8 && Epi::ZC) { if (t == 0) { __builtin_amdgcn_s_setprio(1); \
            _Pragma("unroll") for (int n = 0; n < 2; ++n) { const v8i_t b8_ = PG8_CAT(Bt[n][0], Bt[n][1]); _Pragma("unroll") for (int m = 0; m < 4; ++m) { const v8i_t a8_ = PG8_CAT(At[m][0], At[m][1]); \
                asm volatile("v_mfma_f32_16x16x128_f8f6f4 %0, %1, %2, 0" : "+v"(acc[ai][bj][m][n]) : "v"(b8_), "v"(a8_)); } }     \
            __builtin_amdgcn_s_setprio(0); } else PG8_MMA(ai, bj, At, Bt); } \
        else if constexpr (Epi::ZC) { if (t == 0) { __builtin_amdgcn_s_setprio(1);        \
            _Pragma("unroll") for (int m = 0; m < 4; ++m) _Pragma("unroll") for (int n = 0; n < 2; ++n) { \
                acc[ai][bj][m][n] = __builtin_amdgcn_mfma_f32_16x16x32_bf16(Bt[n][0], At[m][0], (f32x4){0.f, 0.f, 0.f, 0.f}, 0, 0, 0); \
                acc[ai][bj][m][n] = __builtin_amdgcn_mfma_f32_16x16x32_bf16(Bt[n][1], At[m][1], acc[ai][bj][m][n], 0, 0, 0); } \
            __builtin_amdgcn_s_setprio(0); } else PG8_MMA(ai, bj, At, Bt); } \
        else PG8_MMA(ai, bj, At, Bt); } while (0)
#define PG8_WAIT_V(n) asm volatile("s_waitcnt vmcnt(" #n ")" ::: "memory")
#define PG8_WAIT_L(n) asm volatile("s_waitcnt lgkmcnt(" #n ")" ::: "memory")
#define PG8_BAR __builtin_amdgcn_s_barrier()
#define PG8_SCHED __builtin_amdgcn_sched_barrier(0)
    Unit cur, nxt; int ui = 0;
    if (!S.next(0, cur)) return;
    f32x4 acc[2][2][4][2];
    if constexpr (!Epi::ZC) {
#pragma unroll
    for (int a = 0; a < 2; ++a)
#pragma unroll
        for (int b = 0; b < 2; ++b)
#pragma unroll
            for (int m = 0; m < 4; ++m)
#pragma unroll
                for (int n = 0; n < 2; ++n) acc[a][b][m][n] = (f32x4){0.f, 0.f, 0.f, 0.f}; }
    bf16x8 At[4][2], B0[2][2], B1[2][2];
    unsigned ao[2][2] = {{0u, 0u}, {0u, 0u}}, nao[2][2] = {{0u, 0u}, {0u, 0u}};
    unsigned cA = X.a_base(cur); if constexpr (GA) X.a_offs(cur, RA, CA, ao);
    unsigned cB = X.b_base(cur);
    PG8_STAGE(PG8_SB(0, 0), cB, voffB); PG8_STAGE_A(PG8_SA(0, 0), cA, 0, ao[0][0], ao[0][1]); PG8_STAGE(PG8_SB(0, 1), cB + hstep, voffB); PG8_STAGE_A(PG8_SA(0, 1), cA, 1, ao[1][0], ao[1][1]);
    if (wr == 1) PG8_BAR;
    PG8_WAIT_V(4); PG8_BAR;
    PG8_STAGE(PG8_SB(1, 0), cB + kstep, voffB); PG8_STAGE_A(PG8_SA(1, 0), cA + kstepA, 0, ao[0][0], ao[0][1]); PG8_STAGE(PG8_SB(1, 1), cB + hstep + kstep, voffB);
    PG8_WAIT_V(6); PG8_BAR;
    for (;;) {
        const bool has_next = S.next(ui + 1, nxt);
        E.prefetch(cur, ui, wid, lane);
        unsigned nA = cA, nB = cB;
        if constexpr (GA) {
#pragma unroll
            for (int h = 0; h < 2; ++h)
#pragma unroll
                for (int i = 0; i < 2; ++i) nao[h][i] = ao[h][i]; }
        if (has_next) { nA = X.a_base(nxt); nB = X.b_base(nxt); if constexpr (GA) X.idx_prefetch(nxt, wid, lane); }
        for (int t = 0; t < nt; t += 2) {
            const bool last = (t == nt - 2);
            if constexpr (GA) { if (last && has_next) X.a_offs_lds(RA, CA, nao); }
            const unsigned a1 = cA + (unsigned)(t + 1) * kstepA;
            const unsigned a2 = last ? nA : cA + (unsigned)(t + 2) * kstepA, b2 = last ? nB : cB + (unsigned)(t + 2) * kstep;
            const unsigned a3 = a2 + kstepA, b3 = b2 + kstep;
            unsigned s00 = 0u, s01 = 0u, s10 = 0u, s11 = 0u;
            if constexpr (GA) { s00 = last ? nao[0][0] : ao[0][0]; s01 = last ? nao[0][1] : ao[0][1]; s10 = last ? nao[1][0] : ao[1][0]; s11 = last ? nao[1][1] : ao[1][1]; }
            PG8_LDB(B0, 0, 0); PG8_SCHED; PG8_LDA(At, 0, 0); PG8_STAGE_A(PG8_SA(1, 1), a1, 1, ao[1][0], ao[1][1]);
            PG8_WAIT_L(8); PG8_BAR; PG8_WAIT_L(0); PG8_MMA_Z(0, 0, At, B0); PG8_BAR; PG8_SCHED;
            PG8_LDB(B1, 0, 1); PG8_STAGE(PG8_SB(0, 0), b2, voffB);
            PG8_BAR; PG8_WAIT_L(0); PG8_MMA_Z(0, 1, At, B1); PG8_BAR;
            PG8_LDA(At, 0, 1); PG8_STAGE_A(PG8_SA(0, 0), a2, 0, s00, s01);
            PG8_BAR; PG8_WAIT_L(0); PG8_MMA_Z(1, 0, At, B0); PG8_BAR; PG8_SCHED;
            PG8_STAGE(PG8_SB(0, 1), b2 + hstep, voffB);
            PG8_WAIT_V(6); PG8_BAR; PG8_MMA_Z(1, 1, At, B1); PG8_BAR;
            PG8_LDB(B0, 1, 0); PG8_SCHED; PG8_LDA(At, 1, 0); PG8_STAGE_A(PG8_SA(0, 1), a2, 1, s10, s11);
            PG8_WAIT_L(8); PG8_BAR; PG8_WAIT_L(0); PG8_MMA(0, 0, At, B0); PG8_BAR; PG8_SCHED;
            PG8_LDB(B1, 1, 1); PG8_STAGE(PG8_SB(1, 0), b3, voffB);
            PG8_BAR; PG8_WAIT_L(0); PG8_MMA(0, 1, At, B1); PG8_BAR;
            PG8_LDA(At, 1, 1); PG8_STAGE_A(PG8_SA(1, 0), a3, 0, s00, s01);
            PG8_BAR; PG8_WAIT_L(0); PG8_MMA(1, 0, At, B0); PG8_BAR; PG8_SCHED;
            PG8_STAGE(PG8_SB(1, 1), b3 + hstep, voffB);
            PG8_WAIT_V(6); PG8_BAR; PG8_MMA(1, 1, At, B1); PG8_BAR;
        }
        { const int tz = opaque_tid(); const int wz = __builtin_amdgcn_readfirstlane(tz >> 6), lz = tz & 63;
          E(acc, cur, wz >> 2, wz & 3, lz & 15, lz >> 4, ui); }
        if (!has_next) break;
        if constexpr (Epi::ZC) {
#pragma unroll
            for (int a = 0; a < 2; ++a)
#pragma unroll
                for (int b = 0; b < 2; ++b)
#pragma unroll
                    for (int m = 0; m < 4; ++m)
#pragma unroll
                        for (int n = 0; n < 2; ++n) asm volatile("" : "=v"(acc[a][b][m][n])); }
        if constexpr (!Epi::ZC)
#pragma unroll
        for (int a = 0; a < 2; ++a)
#pragma unroll
            for (int b = 0; b < 2; ++b)
#pragma unroll
                for (int m = 0; m < 4; ++m)
#pragma unroll
                    for (int n = 0; n < 2; ++n) acc[a][b][m][n] = (f32x4){0.f, 0.f, 0.f, 0.f};
        cur = nxt; cA = nA; cB = nB; ++ui;
        if constexpr (GA) {
#pragma unroll
            for (int h = 0; h < 2; ++h)
#pragma unroll
                for (int i = 0; i < 2; ++i) ao[h][i] = nao[h][i]; }
    }
    PG8_WAIT_V(0);
    if (wr == 0) PG8_BAR;
    PG8_BAR;
#undef PG8_SA
#undef PG8_SB
#undef PG8_STAGE
#undef PG8_STAGE_R
#undef PG8_STAGE_A
#undef PG8_LDA
#undef PG8_LDB
#undef PG8_MMA
#undef PG8_CAT
#undef PG8_WAIT_V
#undef PG8_WAIT_L
#undef PG8_BAR
#undef PG8_SCHED
}

__device__ __forceinline__ float sigmoidf_(float x) { return __builtin_amdgcn_rcpf(1.0f + __expf(-x)); }
__device__ __forceinline__ f32x4 gelu_tanh4(f32x4 x) {
    f32x4 t = x * (x * x * 0.044715f + 1.0f) * (-2.0f * 0.7978845608028654f * 1.4426950408889634f);
    t[0] = __builtin_amdgcn_exp2f(t[0]); t[1] = __builtin_amdgcn_exp2f(t[1]); t[2] = __builtin_amdgcn_exp2f(t[2]); t[3] = __builtin_amdgcn_exp2f(t[3]);
    t = t + 1.0f;
    t[0] = __builtin_amdgcn_rcpf(t[0]); t[1] = __builtin_amdgcn_rcpf(t[1]); t[2] = __builtin_amdgcn_rcpf(t[2]); t[3] = __builtin_amdgcn_rcpf(t[3]);
    return x * t;
}
__device__ __forceinline__ float gelu_tanh(float x) { const float t = 0.7978845608028654f * (x + 0.044715f * x * x * x); return x * __builtin_amdgcn_rcpf(1.0f + __expf(-2.0f * t)); }

struct EpiIn {
    static constexpr bool PERM = true, ZC = true, PERM64 = false;
    bf16_t* gg; float asc;
    __device__ __forceinline__ void prefetch(const Unit&, int, int, int) const {}
    __device__ __forceinline__ void operator()(const f32x4 (&acc)[2][2][4][2], const Unit& u, int wr, int wc, int fr, int fq, int) const {
        const bool is_gate = u.pn < 4;
        bf16_t* base = gg + (is_gate ? (size_t)0 : (size_t)(32u << 20));
        const int row0 = u.pm * BM + wr * 64 + fr, col0 = (u.pn & 3) * BM + wc * 32 + 8 * fq;
#pragma unroll
        for (int ai = 0; ai < 2; ++ai)
#pragma unroll
            for (int m = 0; m < 4; ++m) { bf16_t* rowp = base + (size_t)(row0 + ai * HALF + m * 16) * D + col0;
#pragma unroll
                for (int bj = 0; bj < 2; ++bj) { f32x4 v0 = acc[ai][bj][m][0] * asc, v1 = acc[ai][bj][m][1] * asc;
                    if (is_gate) { v0 = gelu_tanh4(v0); v1 = gelu_tanh4(v1); }
                    if (FP8_SCAN && is_gate) { v0 = v0 * SCAN_SC; v1 = v1 * SCAN_SC; u32x2 w; w.x = pk4_fp8(v0[0], v0[1], v0[2], v0[3]); w.y = pk4_fp8(v1[0], v1[1], v1[2], v1[3]);
                        *(u32x2*)((unsigned char*)gg + (size_t)(row0 + ai * HALF + m * 16) * D + col0 + bj * HALF) = w; }
                    else { u32x4 w; w.x = cvt_pk_bf16(v0[0], v0[1]); w.y = cvt_pk_bf16(v0[2], v0[3]); w.z = cvt_pk_bf16(v1[0], v1[1]); w.w = cvt_pk_bf16(v1[2], v1[3]);
                    *(u32x4*)(rowp + bj * HALF) = w; } } }
    }
};
struct EpiQKV {
    static constexpr bool PERM64 = false; static constexpr bool PERM = true, ZC = true;
    static constexpr float asc = FP8_QKV ? (1.0f / 32.0f) : 1.0f;
    __device__ __forceinline__ void prefetch(const Unit&, int, int, int) const {}
    __device__ __forceinline__ void operator()(const f32x4 (&acc)[2][2][4][2], const Unit& u, int wr, int wc, int fr, int fq, int) const {
        const int which = u.pn >> 2;
        unsigned char* wsb = (unsigned char*)arg_ptr(23);
        bf16_t* base = (bf16_t*)(wsb + WS_Q) + (size_t)which * (size_t)(32u << 20);
        float* ksum = (float*)(wsb + WS_KMH);
        const int row0 = u.pm * BM + wr * 64 + fr, col0 = (u.pn & 3) * BM + wc * 32 + 8 * fq;
        f32x4 ks[2][2] = {};
        float crev[4];
#pragma unroll
        for (int j = 0; j < 4; ++j) crev[j] = __builtin_amdgcn_exp2f(-(float)(16 * wc + 4 * fq + j) * (13.287712379549449f / 64.0f)) * 0.15915494309189535f;
#pragma unroll
        for (int ai = 0; ai < 2; ++ai)
#pragma unroll
            for (int m = 0; m < 4; ++m) { const int row = row0 + ai * HALF + m * 16; bf16_t* rowp = base + (size_t)row * D + col0;
                float c0 = 1.f, c1 = 1.f, c2 = 1.f, c3 = 1.f, s0 = 0.f, s1 = 0.f, s2 = 0.f, s3 = 0.f;
                if (which < 2) { const float sp = (float)(row & (SEQ - 1));
                    const float x0 = __builtin_amdgcn_fractf(sp * crev[0]), x1 = __builtin_amdgcn_fractf(sp * crev[1]), x2 = __builtin_amdgcn_fractf(sp * crev[2]), x3 = __builtin_amdgcn_fractf(sp * crev[3]);
                    c0 = __builtin_amdgcn_cosf(x0); c1 = __builtin_amdgcn_cosf(x1); c2 = __builtin_amdgcn_cosf(x2); c3 = __builtin_amdgcn_cosf(x3);
                    s0 = __builtin_amdgcn_sinf(x0); s1 = __builtin_amdgcn_sinf(x1); s2 = __builtin_amdgcn_sinf(x2); s3 = __builtin_amdgcn_sinf(x3); }
                const f32x4 cs = (f32x4){c0, c1, c2, c3}, sn = (f32x4){s0, s1, s2, s3};
#pragma unroll
                for (int bj = 0; bj < 2; ++bj) { const f32x4 t1 = acc[ai][bj][m][0] * asc, t2 = acc[ai][bj][m][1] * asc;
                    const f32x4 o1 = t1 * cs - t2 * sn, o2 = t2 * cs + t1 * sn;
                    ks[bj][0] += o1; ks[bj][1] += o2;
                    u32x4 w; w.x = cvt_pk_bf16(o1[0], o1[1]); w.y = cvt_pk_bf16(o1[2], o1[3]); w.z = cvt_pk_bf16(o2[0], o2[1]); w.w = cvt_pk_bf16(o2[2], o2[3]);
                    *(u32x4*)(rowp + bj * HALF) = w; } }
        if (which == 1) {
            float* kp = ksum + (size_t)u.pm * D + col0;
#pragma unroll
            for (int bj = 0; bj < 2; ++bj)
#pragma unroll
                for (int h2 = 0; h2 < 2; ++h2)
#pragma unroll
                    for (int e = 0; e < 4; ++e) { float v = ks[bj][h2][e];
                        v += dppf<0xB1>(v); v += dppf<0x4E>(v); v += dppf<0x141>(v); v += dppf<0x140>(v);
                        if (fr == 0) __hip_atomic_fetch_add(kp + bj * HALF + 4 * h2 + e, v, __ATOMIC_RELAXED, __HIP_MEMORY_SCOPE_AGENT); } }
    }
};
struct EpiOut {
    static constexpr bool PERM = true, ZC = true, PERM64 = false;
    void* z; const bf16_t* xres; float asc;
    __device__ __forceinline__ void prefetch(const Unit&, int, int, int) const {}
    __device__ __forceinline__ void operator()(const f32x4 (&acc)[2][2][4][2], const Unit& u, int wr, int wc, int fr, int fq, int) const {
        const int row0 = u.pm * BM + wr * 64 + fr, col0 = u.pn * BM + wc * 32 + 8 * fq;
        u32x4 xw[2][4][2];
#pragma unroll
        for (int ai = 0; ai < 2; ++ai)
#pragma unroll
            for (int m = 0; m < 4; ++m)
#pragma unroll
                for (int bj = 0; bj < 2; ++bj) xw[ai][m][bj] = *(const u32x4*)(xres + (size_t)(row0 + ai * HALF + m * 16) * D + col0 + bj * HALF);
#pragma unroll
        for (int ai = 0; ai < 2; ++ai)
#pragma unroll
            for (int m = 0; m < 4; ++m) { const size_t off = (size_t)(row0 + ai * HALF + m * 16) * D + col0;
#pragma unroll
                for (int bj = 0; bj < 2; ++bj) { const u32x4 w4 = xw[ai][m][bj];
                    const f32x4 x0 = (f32x4){bflo(w4.x), bfhi(w4.x), bflo(w4.y), bfhi(w4.y)}, x1 = (f32x4){bflo(w4.z), bfhi(w4.z), bflo(w4.w), bfhi(w4.w)};
                    const f32x4 v0 = FP8_OUT ? acc[ai][bj][m][0] * asc + x0 * ALPHA : acc[ai][bj][m][0] + x0 * ALPHA, v1 = FP8_OUT ? acc[ai][bj][m][1] * asc + x1 * ALPHA : acc[ai][bj][m][1] + x1 * ALPHA;
                    if (Z_F32) { *(f32x4*)((float*)z + off + bj * HALF) = v0; *(f32x4*)((float*)z + off + bj * HALF + 4) = v1; }
                    else { u32x4 w; w.x = cvt_pk_bf16(v0[0], v0[1]); w.y = cvt_pk_bf16(v0[2], v0[3]); w.z = cvt_pk_bf16(v1[0], v1[1]); w.w = cvt_pk_bf16(v1[2], v1[3]);
                    *(u32x4*)((bf16_t*)z + off + bj * HALF) = w; } } }
    }
};
struct EpiGates {
    static constexpr bool PERM = true, ZC = true, PERM64 = false;
    bf16_t* la; bf16_t* bb; const bf16_t* ub; const float* bga; const float* bgx; const float* lam;
    __device__ __forceinline__ void prefetch(const Unit&, int, int, int) const {}
    __device__ __forceinline__ void operator()(const f32x4 (&acc)[2][2][4][2], const Unit& u, int wr, int wc, int fr, int fq, int) const {
        const int row0 = u.pm * BM + wr * 64 + fr, ch0 = u.pn * HALF + wc * 32 + 8 * fq;
        f32x4 ba[2], bx[2], ls[2];
#pragma unroll
        for (int n = 0; n < 2; ++n) { ba[n] = *(const f32x4*)(bga + ch0 + n * 4); bx[n] = *(const f32x4*)(bgx + ch0 + n * 4); const f32x4 l = *(const f32x4*)(lam + ch0 + n * 4);
#pragma unroll
            for (int j = 0; j < 4; ++j) ls[n][j] = -8.0f * log1pf(__expf(-l[j])); }
        u32x4 uws[2][4];
#pragma unroll
        for (int ai = 0; ai < 2; ++ai)
#pragma unroll
            for (int m = 0; m < 4; ++m) uws[ai][m] = *(const u32x4*)(ub + (size_t)(row0 + ai * HALF + m * 16) * D + ch0);
#pragma unroll
        for (int ai = 0; ai < 2; ++ai)
#pragma unroll
            for (int m = 0; m < 4; ++m) { const int row = row0 + ai * HALF + m * 16; const size_t off = (size_t)row * D + ch0; const bool first = (row & (SEQ - 1)) == 0;
                const u32x4 uw = uws[ai][m];
                const float uv[2][4] = {{bflo(uw.x), bfhi(uw.x), bflo(uw.y), bfhi(uw.y)}, {bflo(uw.z), bfhi(uw.z), bflo(uw.w), bfhi(uw.w)}};
                f32x4 lo[2], bo[2];
#pragma unroll
                for (int n = 0; n < 2; ++n)
#pragma unroll
                    for (int j = 0; j < 4; j += 2) {
                        f32x2 ea = ((f32x2){acc[ai][0][m][n][j], acc[ai][0][m][n][j + 1]} + (f32x2){ba[n][j], ba[n][j + 1]}) * -1.4426950408889634f;
                        f32x2 ex = ((f32x2){acc[ai][1][m][n][j], acc[ai][1][m][n][j + 1]} + (f32x2){bx[n][j], bx[n][j + 1]}) * -1.4426950408889634f;
                        ea[0] = __builtin_amdgcn_exp2f(ea[0]); ea[1] = __builtin_amdgcn_exp2f(ea[1]); ex[0] = __builtin_amdgcn_exp2f(ex[0]); ex[1] = __builtin_amdgcn_exp2f(ex[1]);
                        ea = ea + 1.0f; ex = ex + 1.0f;
                        f32x2 sa, sx; sa[0] = __builtin_amdgcn_rcpf(ea[0]); sa[1] = __builtin_amdgcn_rcpf(ea[1]); sx[0] = __builtin_amdgcn_rcpf(ex[0]); sx[1] = __builtin_amdgcn_rcpf(ex[1]);
                        const f32x2 l2 = sa * (f32x2){ls[n][j], ls[n][j + 1]}; const f32x2 t2 = l2 * -2.0f;
                        const f32x2 ser = t2 * (t2 * -0.5f + 1.0f); f32x2 dx = t2 * -1.4426950408889634f; dx[0] = __builtin_amdgcn_exp2f(dx[0]); dx[1] = __builtin_amdgcn_exp2f(dx[1]); dx = 1.0f - dx;
                        f32x2 mult; mult[0] = first ? 1.0f : __builtin_amdgcn_sqrtf(t2[0] < 1e-3f ? ser[0] : dx[0]); mult[1] = first ? 1.0f : __builtin_amdgcn_sqrtf(t2[1] < 1e-3f ? ser[1] : dx[1]);
                        const f32x2 b2 = mult * sx * (f32x2){uv[n][j], uv[n][j + 1]};
                        lo[n][j] = l2[0]; lo[n][j + 1] = l2[1]; bo[n][j] = b2[0]; bo[n][j + 1] = b2[1]; }
                u32x4 w; w.x = cvt_pk_bf16(lo[0][0], lo[0][1]); w.y = cvt_pk_bf16(lo[0][2], lo[0][3]); w.z = cvt_pk_bf16(lo[1][0], lo[1][1]); w.w = cvt_pk_bf16(lo[1][2], lo[1][3]);
                *(u32x4*)(la + off) = w;
                if (FP8_SCAN) { const f32x4 s0 = bo[0] * SCAN_SC, s1 = bo[1] * SCAN_SC; u32x2 w8; w8.x = pk4_fp8(s0[0], s0[1], s0[2], s0[3]); w8.y = pk4_fp8(s1[0], s1[1], s1[2], s1[3]); *(u32x2*)((unsigned char*)bb + off) = w8; }
                else { w.x = cvt_pk_bf16(bo[0][0], bo[0][1]); w.y = cvt_pk_bf16(bo[0][2], bo[0][3]); w.z = cvt_pk_bf16(bo[1][0], bo[1][1]); w.w = cvt_pk_bf16(bo[1][2], bo[1][3]);
                *(u32x4*)(bb + off) = w; } }
    }
};
template <bool IN8, bool OUT8> struct EpiGU {
    static constexpr bool PERM = true, ZC = true, PERM64 = false;
    void* hb; const float* bgu; const LAS unsigned char* tile_e; LAS float* bl;
    __device__ __forceinline__ void prefetch(const Unit& u, int ui, int wid, int lane) const {
        if (wid < 4) { const int e = __builtin_amdgcn_readfirstlane((int)tile_e[u.pm]);
            const float* src = bgu + (size_t)e * 2048 + (wid >> 1) * 1024 + u.pn * HALF + (wid & 1) * 64 + lane;
            __builtin_amdgcn_global_load_lds((const unsigned*)src, (LAS unsigned*)(bl + (ui & 1) * 256 + wid * 64), 4, 0, 0); }
    }
    __device__ __forceinline__ void operator()(const f32x4 (&acc)[2][2][4][2], const Unit& u, int wr, int wc, int fr, int fq, int ui) const {
        const int row0 = u.pm * BM + wr * 64 + fr, col0 = u.pn * HALF + wc * 32 + 8 * fq;
        const LAS float* bp = bl + (ui & 1) * 256 + wc * 32 + 8 * fq;
        const f32x4 bg0 = *(const LAS f32x4*)(bp), bg1 = *(const LAS f32x4*)(bp + 4), bu0 = *(const LAS f32x4*)(bp + 128) + 1.0f, bu1 = *(const LAS f32x4*)(bp + 132) + 1.0f;
#pragma unroll
        for (int ai = 0; ai < 2; ++ai)
#pragma unroll
            for (int m = 0; m < 4; ++m) { const size_t eoff = (size_t)(row0 + ai * HALF + m * 16) * D + col0; constexpr float asc = IN8 ? (1.0f / 32.0f) : 1.0f;
                f32x4 h0, h1;
                { f32x2 g2[4], u2[4], e2[4], r2[4];
#pragma unroll
                  for (int q = 0; q < 4; ++q) { const int N_ = q >> 1, J0 = (q & 1) * 2; const f32x4 BG = N_ ? bg1 : bg0, BU = N_ ? bu1 : bu0;
                      g2[q] = __builtin_elementwise_fma((f32x2){acc[ai][0][m][N_][J0], acc[ai][0][m][N_][J0 + 1]}, (f32x2){asc, asc}, (f32x2){BG[J0], BG[J0 + 1]});
                      u2[q] = __builtin_elementwise_fma((f32x2){acc[ai][1][m][N_][J0], acc[ai][1][m][N_][J0 + 1]}, (f32x2){asc, asc}, (f32x2){BU[J0], BU[J0 + 1]}); }
#pragma unroll
                  for (int q = 0; q < 4; ++q) { g2[q][0] = fminf(g2[q][0], 7.0f); g2[q][1] = fminf(g2[q][1], 7.0f); u2[q][0] = __builtin_amdgcn_fmed3f(u2[q][0], -6.0f, 8.0f); u2[q][1] = __builtin_amdgcn_fmed3f(u2[q][1], -6.0f, 8.0f); }
#pragma unroll
                  for (int q = 0; q < 4; ++q) e2[q] = g2[q] * -2.45546696f;
#pragma unroll
                  for (int q = 0; q < 4; ++q) { e2[q][0] = __builtin_amdgcn_exp2f(e2[q][0]); e2[q][1] = __builtin_amdgcn_exp2f(e2[q][1]); }
#pragma unroll
                  for (int q = 0; q < 4; ++q) e2[q] = e2[q] + 1.0f;
#pragma unroll
                  for (int q = 0; q < 4; ++q) { r2[q][0] = __builtin_amdgcn_rcpf(e2[q][0]); r2[q][1] = __builtin_amdgcn_rcpf(e2[q][1]); }
#pragma unroll
                  for (int q = 0; q < 4; ++q) { const f32x2 hh = u2[q] * (g2[q] * r2[q]); if (q < 2) { h0[(q & 1) * 2] = hh[0]; h0[(q & 1) * 2 + 1] = hh[1]; } else { h1[(q & 1) * 2] = hh[0]; h1[(q & 1) * 2 + 1] = hh[1]; } } }
                if constexpr (OUT8) { u32x2 w; w.x = pk4_fp8(h0[0], h0[1], h0[2], h0[3]); w.y = pk4_fp8(h1[0], h1[1], h1[2], h1[3]);
                    if (H_BLOCKED) *(u32x2*)((unsigned char*)hb + ((size_t)((u.pm * 8 + u.pn) * 4 + wc) * 256 + (wr * 64 + fr + ai * HALF + m * 16)) * 32 + 8 * fq) = w;
                    else *(u32x2*)((unsigned char*)hb + eoff) = w; }
                else { u32x4 w; w.x = cvt_pk_bf16(h0[0], h0[1]); w.y = cvt_pk_bf16(h0[2], h0[3]); w.z = cvt_pk_bf16(h1[0], h1[1]); w.w = cvt_pk_bf16(h1[2], h1[3]); *(u32x4*)((bf16_t*)hb + eoff) = w; } }
    }
};
template <bool IN8> struct EpiDown {
    static constexpr bool PERM = true, ZC = true, PERM64 = Y_F8 != 0;
    void* yb; const float* bdn; const LAS unsigned char* tile_e; LAS float* bl;
    __device__ __forceinline__ void prefetch(const Unit& u, int ui, int wid, int lane) const {
        if (wid < 4) { const int e = __builtin_amdgcn_readfirstlane((int)tile_e[u.pm]);
            __builtin_amdgcn_global_load_lds((const unsigned*)(bdn + (size_t)e * D + u.pn * BM + wid * 64 + lane), (LAS unsigned*)(bl + (ui & 1) * 256 + wid * 64), 4, 0, 0); }
    }
    __device__ __forceinline__ void operator()(const f32x4 (&acc)[2][2][4][2], const Unit& u, int wr, int wc, int fr, int fq, int ui) const {
        constexpr float asc = (IN8 ? (1.0f / 64.0f) : 1.0f) * (Y_F8 ? 16.0f : 1.0f);
        if constexpr (Y_F8) {
            const int row0 = u.pm * BM + wr * 64 + fr, col0 = u.pn * BM + wc * 64 + 16 * fq;
            f32x4 bv[2][2];
#pragma unroll
            for (int bj = 0; bj < 2; ++bj)
#pragma unroll
                for (int n = 0; n < 2; ++n) bv[bj][n] = *(const LAS f32x4*)(bl + (ui & 1) * 256 + wc * 64 + 16 * fq + 8 * bj + 4 * n) * 16.0f;
#pragma unroll
            for (int ai = 0; ai < 2; ++ai)
#pragma unroll
                for (int m = 0; m < 4; ++m) { u32x4 w;
#pragma unroll
                    for (int bj = 0; bj < 2; ++bj)
#pragma unroll
                        for (int n = 0; n < 2; ++n) { const f32x4 v = __builtin_elementwise_fma(acc[ai][bj][m][n], (f32x4){asc, asc, asc, asc}, bv[bj][n]); w[2 * bj + n] = pk4_fp8(v[0], v[1], v[2], v[3]); }
                    *(u32x4*)((unsigned char*)yb + (size_t)(row0 + ai * HALF + m * 16) * D + col0) = w; }
        } else {
            const int row0 = u.pm * BM + wr * 64 + fr, col0 = u.pn * BM + wc * 32 + 8 * fq;
            f32x4 bv[2][2];
#pragma unroll
            for (int bj = 0; bj < 2; ++bj)
#pragma unroll
                for (int n = 0; n < 2; ++n) bv[bj][n] = *(const LAS f32x4*)(bl + (ui & 1) * 256 + bj * HALF + wc * 32 + 8 * fq + 4 * n);
#pragma unroll
            for (int ai = 0; ai < 2; ++ai)
#pragma unroll
                for (int m = 0; m < 4; ++m) { const size_t eoff = (size_t)(row0 + ai * HALF + m * 16) * D + col0;
#pragma unroll
                    for (int bj = 0; bj < 2; ++bj) { const f32x4 v0 = __builtin_elementwise_fma(acc[ai][bj][m][0], (f32x4){asc, asc, asc, asc}, bv[bj][0]), v1 = __builtin_elementwise_fma(acc[ai][bj][m][1], (f32x4){asc, asc, asc, asc}, bv[bj][1]);
                        u32x4 w; w.x = cvt_pk_bf16(v0[0], v0[1]); w.y = cvt_pk_bf16(v0[2], v0[3]); w.z = cvt_pk_bf16(v1[0], v1[1]); w.w = cvt_pk_bf16(v1[2], v1[3]);
                        *(u32x4*)((bf16_t*)yb + eoff + bj * HALF) = w; } }
        }
    }
};
}

namespace moba {
constexpr int HD = 128, LD = 1024;
constexpr float SCALE = 0.08838834764831845f;
constexpr float THR = 8.f;
constexpr int NW = 8, QBLK = 32, KVBLK = 64, QB = NW * QBLK;
constexpr int SHM_V = KVBLK * HD * 2, SHM_K = KVBLK * HD * 2;
constexpr int G_OFF = 2 * SHM_V + 2 * SHM_K + NW * 64 * 4;
constexpr int LDS_ATT = G_OFF + 8192;

#define KSWZ(row, colB) ((row) * 256 + ((colB) ^ (((row) & 7) << 4)))
#define SBAR() __builtin_amdgcn_sched_barrier(0)
__device__ __forceinline__ int v_st(int k, int c) { const int kk = (k & ~0xC) | ((k & 4) << 1) | ((k & 8) >> 1); return ((kk >> 3) * 4 + (c >> 5)) * 512 + ((kk & 7) * 32 + (c & 31)) * 2; }
__device__ __forceinline__ int v_rd_base(int lane) { return ((lane & 3) << 3) | (((lane >> 2) & 3) << 6) | (((lane >> 4) & 1) << 5) | (((lane >> 5) & 1) << 8); }
constexpr int v_rd_off(int d0, int ks, int half) { return d0 * 512 + ks * 4096 + half * 2048; }
__device__ __forceinline__ int crow(int r, int hi) { return (r & 3) + 8 * (r >> 2) + 4 * hi; }
__device__ __forceinline__ unsigned cvtpk(float lo, float hi) { unsigned r; asm volatile("v_cvt_pk_bf16_f32 %0, %1, %2" : "=v"(r) : "v"(lo), "v"(hi)); return r; }
__device__ __forceinline__ bf16x8 load8(const bf16_t* p) { return *reinterpret_cast<const bf16x8*>(p); }
__device__ __forceinline__ void mask_tile(f32x16& p0, f32x16& p1, int dq) {
    const float NEG = -__builtin_inff();
#pragma unroll
    for (int r = 0; r < 16; ++r) {
        const int c = (r & 3) + 8 * (r >> 2);
        if (dq - c < 0) p0[r] = NEG;
        if (dq - c - 32 < 0) p1[r] = NEG;
    }
}
__device__ __forceinline__ void partialSM(f32x16& p0, f32x16& p1, float& m_reg, float& mn, float& alpha, bool keep = true) {
    float pmax = p0[0];
#pragma unroll
    for (int r = 1; r < 16; ++r) pmax = fmaxf(pmax, p0[r]);
#pragma unroll
    for (int r = 0; r < 16; ++r) pmax = fmaxf(pmax, p1[r]);
    { auto rr = __builtin_amdgcn_permlane32_swap(__float_as_uint(pmax), __float_as_uint(pmax), false, false);
      pmax = fmaxf(__uint_as_float(rr[0]), __uint_as_float(rr[1])); }
    pmax = keep ? pmax : -__builtin_inff();
    constexpr float C2 = 1.4426950408889634f * SCALE;
    if (__builtin_expect(__all((pmax - m_reg) * SCALE <= THR), 1)) { mn = m_reg; alpha = 1.f; }
    else { mn = fmaxf(m_reg, pmax); alpha = __builtin_amdgcn_exp2f((m_reg - mn) * C2); m_reg = mn; }
    const float mnL = keep ? -mn * C2 : -__builtin_inff();
#pragma unroll
    for (int r = 0; r < 16; ++r) p0[r] = fmaf(p0[r], C2, mnL);
#pragma unroll
    for (int r = 0; r < 16; ++r) p1[r] = fmaf(p1[r], C2, mnL);
#pragma unroll
    for (int r = 0; r < 16; ++r) p0[r] = __builtin_amdgcn_exp2f(p0[r]);
}
__device__ __forceinline__ void finishSM(f32x16& p0, f32x16& p1, float alpha, float& l_reg, bf16x8& pa0, bf16x8& pa1, bf16x8& pa2, bf16x8& pa3) {
#pragma unroll
    for (int r = 0; r < 16; ++r) p1[r] = __builtin_amdgcn_exp2f(p1[r]);
    float ps = 0;
#pragma unroll
    for (int r = 0; r < 16; ++r) ps += p0[r];
#pragma unroll
    for (int r = 0; r < 16; ++r) ps += p1[r];
    { auto rr = __builtin_amdgcn_permlane32_swap(__float_as_uint(ps), __float_as_uint(ps), false, false);
      ps = __uint_as_float(rr[0]) + __uint_as_float(rr[1]); }
    l_reg = l_reg * alpha + ps;
#define PK4(P, B_, OUT) do { unsigned a0 = cvtpk(P[B_+0], P[B_+1]), a1 = cvtpk(P[B_+2], P[B_+3]);                          \
        unsigned b0 = cvtpk(P[B_+4], P[B_+5]), b1 = cvtpk(P[B_+6], P[B_+7]);                                             \
        auto r0 = __builtin_amdgcn_permlane32_swap(a0, b0, false, false); auto r1 = __builtin_amdgcn_permlane32_swap(a1, b1, false, false); \
        u32x4 w = {r0[0], r1[0], r0[1], r1[1]}; OUT = *reinterpret_cast<bf16x8*>(&w); } while (0)
    PK4(p0, 0, pa0); PK4(p0, 8, pa1); PK4(p1, 0, pa2); PK4(p1, 8, pa3);
#undef PK4
}
template <int KB>
__device__ __forceinline__ void qkt(f32x16& p0, f32x16& p1, const char* K_lds, int r32, int hi, const bf16x8* qr) {
    p0 = f32x16{}; p1 = f32x16{};
    const char* kb[4];
#pragma unroll
    for (int dd = 0; dd < 4; ++dd) kb[dd] = K_lds + KB * SHM_K + KSWZ(r32, (dd * 16 + hi * 8) * 2);
#pragma unroll
    for (int d0 = 0; d0 < 8; ++d0) { const char* a = kb[d0 & 3] + (d0 >> 2) * 128;
        bf16x8 b0 = *reinterpret_cast<const bf16x8*>(a);
        bf16x8 b1 = *reinterpret_cast<const bf16x8*>(a + 32 * 256);
        p0 = __builtin_amdgcn_mfma_f32_32x32x16_bf16(b0, qr[d0], p0, 0, 0, 0);
        p1 = __builtin_amdgcn_mfma_f32_32x32x16_bf16(b1, qr[d0], p1, 0, 0, 0); }
}
template <int VB>
__device__ __forceinline__ void pv_tile(f32x16* o, int vb0, bf16x8 pa0, bf16x8 pa1, bf16x8 pa2, bf16x8 pa3) {
#define TRRD(dst, off) asm volatile("ds_read_b64_tr_b16 %0, %1 offset:%2" : "=&v"(dst) : "v"(vb0), "i"(off) : "memory")
#define PV_D0(d0) do { s16x4 l0, l1, l2, l3, h0, h1, h2, h3; constexpr int b_ = VB * SHM_V + v_rd_off(d0, 0, 0); \
        TRRD(l0, b_); TRRD(h0, b_ + 2048); TRRD(l1, b_ + 4096); TRRD(h1, b_ + 6144); TRRD(l2, b_ + 8192); TRRD(h2, b_ + 10240); TRRD(l3, b_ + 12288); TRRD(h3, b_ + 14336); \
        asm volatile("s_waitcnt lgkmcnt(0)" ::: "memory"); SBAR();   \
        o[d0] = __builtin_amdgcn_mfma_f32_32x32x16_bf16(pa0, (bf16x8){l0[0], l0[1], l0[2], l0[3], h0[0], h0[1], h0[2], h0[3]}, o[d0], 0, 0, 0);   \
        o[d0] = __builtin_amdgcn_mfma_f32_32x32x16_bf16(pa1, (bf16x8){l1[0], l1[1], l1[2], l1[3], h1[0], h1[1], h1[2], h1[3]}, o[d0], 0, 0, 0);   \
        o[d0] = __builtin_amdgcn_mfma_f32_32x32x16_bf16(pa2, (bf16x8){l2[0], l2[1], l2[2], l2[3], h2[0], h2[1], h2[2], h2[3]}, o[d0], 0, 0, 0);   \
        o[d0] = __builtin_amdgcn_mfma_f32_32x32x16_bf16(pa3, (bf16x8){l3[0], l3[1], l3[2], l3[3], h3[0], h3[1], h3[2], h3[3]}, o[d0], 0, 0, 0); } while (0)
    PV_D0(0); PV_D0(1); PV_D0(2); PV_D0(3);
#undef PV_D0
#undef TRRD
}

struct BlockRef { int qo, kvo, kmo, qb; };
struct Bases { const bf16_t* Q; const bf16_t* K; const bf16_t* V; bf16_t* O; const float* KS; };
__device__ __forceinline__ bf16x8 kmean8(const float* p, int lo) {
    const f32x4 a = *(const f32x4*)p * (1.0f / 256.0f), b = *(const f32x4*)(p + 4) * (1.0f / 256.0f);
    const float v[8] = {a[0], a[1], a[2], a[3], b[0], b[1], b[2], b[3]}; unsigned short o[8];
#pragma unroll
    for (int e = 0; e < 8; ++e) { const unsigned h = f2bf(v[e]); o[e] = (unsigned short)(lo ? f2bf(v[e] - __uint_as_float(h << 16)) : h); }
    return (bf16x8){(short)o[0], (short)o[1], (short)o[2], (short)o[3], (short)o[4], (short)o[5], (short)o[6], (short)o[7]};
}
struct Seam { bf16x8 qr[8]; bf16x8 st_v0, st_v1, st_k0, st_k1; };

#define ROW(p, k0, rr) ((p) + (size_t)((k0) + (rr)) * LD + sc)
#define VMW() asm volatile("s_waitcnt vmcnt(0)" ::: "memory")
#define VMWN(n) asm volatile("s_waitcnt vmcnt(%0)" :: "i"(n) : "memory")
#define SLOAD_H(Kp, Vp, k0) do { S.st_v0 = load8(ROW(Vp, k0, sr)); S.st_v1 = load8(ROW(Vp, k0, 32 + sr));              \
                         S.st_k0 = load8(ROW(Kp, k0, sr)); S.st_k1 = load8(ROW(Kp, k0, 32 + sr)); } while (0)
#define SWRITE_HK(bf) do { *(bf16x8*)(K_lds + (bf) * SHM_K + kws) = S.st_k0; *(bf16x8*)(K_lds + (bf) * SHM_K + kws + 32 * 256) = S.st_k1; } while (0)
#define SWRITE_HV(bf) do { *(bf16x8*)(V_lds + (bf) * SHM_V + vst0) = S.st_v0; *(bf16x8*)(V_lds + (bf) * SHM_V + vst1) = S.st_v1; } while (0)
#define SWRITE_H(bf) do { SWRITE_HV(bf); SWRITE_HK(bf); } while (0)
#define GLOAD(ref, tq) (kmean8(BP.KS + (size_t)(ref).kmo + (size_t)(((tq) & 255) >> 4) * LD + ((tq) & 15) * 8, (tq) >> 8))
#define GWRITE(val, tq) do { *(bf16x8*)(lds + G_OFF + ((tq) >> 8) * 4096 + KSWZ(((tq) & 255) >> 4, ((tq) & 15) * 16)) = (val); } while (0)

__device__ __forceinline__ void moba_prime(const Bases& BP, const BlockRef& cur, char* lds, Seam& S) {
    const int tid = opaque_tid(), wid = __builtin_amdgcn_readfirstlane(tid >> 6), lane = tid & 63, r32 = lane & 31, hi = lane >> 5;
    const int sr = tid >> 4, sc = (tid & 15) * 8, kws = KSWZ(sr, sc * 2); char* K_lds = lds + 2 * SHM_V;
#pragma unroll
    for (int d0 = 0; d0 < 8; ++d0) S.qr[d0] = load8(BP.Q + (size_t)cur.qo + (size_t)(wid * QBLK + r32) * LD + d0 * 16 + hi * 8);
    const bf16x8 gv = GLOAD(cur, tid);
    SLOAD_H(BP.K + (size_t)cur.kvo, BP.V + (size_t)cur.kvo, 0); VMW(); SWRITE_HK(0); GWRITE(gv, tid);
    __syncthreads();
}
__device__ __forceinline__ void moba_block(const Bases& BP, const BlockRef& cur, const BlockRef& nxt, char* lds, Seam& S) {
    int tid_ = threadIdx.x; asm volatile("" : "+v"(tid_));
    const int tid = tid_, wid = __builtin_amdgcn_readfirstlane(tid >> 6), lane = tid & 63, r32 = lane & 31, hi = lane >> 5;
    const int P0 = cur.qb * QB;
    const int NT = (cur.qb + 1) * 4;
    const int qlo = P0 + wid * QBLK, qm = qlo + r32 - 4 * hi;
    char* V_lds = lds; char* K_lds = lds + 2 * SHM_V;
    float* ws = (float*)(lds + 2 * SHM_V + 2 * SHM_K) + wid * 64; float* li_l = ws, * al_l = ws + 32;
    int sel;
    if (cur.qb <= 3) sel = (1 << cur.qb) - 1;
    else {
        f32x16 g = f32x16{};
        const char* gb = lds + G_OFF;
#pragma unroll
        for (int d0 = 0; d0 < 8; ++d0) { const int off = KSWZ(r32 & 15, (d0 * 16 + hi * 8) * 2);
            const bf16x8 ah = *reinterpret_cast<const bf16x8*>(gb + off), al = *reinterpret_cast<const bf16x8*>(gb + 4096 + off);
            g = __builtin_amdgcn_mfma_f32_32x32x16_bf16(ah, S.qr[d0], g, 0, 0, 0);
            g = __builtin_amdgcn_mfma_f32_32x32x16_bf16(al, S.qr[d0], g, 0, 0, 0); }
        float s[16];
#pragma unroll
        for (int r = 0; r < 8; ++r) { const float mine = g[r]; const float other = __shfl_xor(mine, 32);
            const int b0 = (r & 3) + 8 * (r >> 2);
            s[b0] = hi ? other : mine; s[b0 + 4] = hi ? mine : other; }
        sel = 0;
#pragma unroll
        for (int round = 0; round < 3; ++round) { float best = -__builtin_inff(); int bi = 0;
#pragma unroll
            for (int j = 0; j < 16; ++j) { const bool ok = (j < cur.qb) && !((sel >> j) & 1); const float v = ok ? s[j] : -__builtin_inff(); if (v > best) { best = v; bi = j; } }
            sel |= 1 << bi; }
    }
    float m_reg = -1e30f, l_reg = 0; f32x16 o[4] = {};
    const int sr = tid >> 4, sc = (tid & 15) * 8, vst0 = v_st(sr, sc), vst1 = v_st(32 + sr, sc), kws = KSWZ(sr, sc * 2);
    const int vb0 = (int)(uintptr_t)V_lds + v_rd_base(lane);
    const bf16_t* Kh = BP.K + (size_t)cur.kvo; const bf16_t* Vh = BP.V + (size_t)cur.kvo;
#define RESC(a) do { if (__any((a) < 1.f)) { if (hi == 0) al_l[r32] = (a); asm volatile("s_waitcnt lgkmcnt(0)" ::: "memory");              \
                     for (int d_ = 0; d_ < 4; ++d_) for (int r = 0; r < 16; ++r) o[d_][r] *= al_l[crow(r, hi)]; } } while (0)
#define KBASE(t) ((t) * KVBLK)
#define MASKT(P0_, P1_, t) do { const int kb_ = KBASE(t); if (kb_ >= P0 && kb_ + KVBLK - 1 > qlo) mask_tile(P0_, P1_, qm - kb_); } while (0)
#define KEEPT(t) ((KBASE(t) >= P0) || ((sel >> (KBASE(t) >> 8)) & 1))
    constexpr int NQL = 8;
#define SEAM_K0() do { VMWN(NQL); SWRITE_HK(0); SBAR(); } while (0)
    f32x16 pA0, pA1, pB0, pB1; float mnA, mnB, alA, alB; bf16x8 pa0, pa1, pa2, pa3;
    SWRITE_HV(0); SBAR();
    if (NT > 1) { SLOAD_H(Kh, Vh, KBASE(1)); }
    SBAR(); qkt<0>(pA0, pA1, K_lds, r32, hi, S.qr);
    MASKT(pA0, pA1, 0); partialSM(pA0, pA1, m_reg, mnA, alA, KEEPT(0));
    if (NT > 1) { VMW(); SWRITE_H(1); }
    __syncthreads();
#define HALF_STEP(PX0, PX1, mnX, alX, PY0, PY1, alY, t, KB, VB, SB) do {                                                      \
        SBAR(); qkt<KB>(PX0, PX1, K_lds, r32, hi, S.qr);                                             \
        finishSM(PY0, PY1, alY, l_reg, pa0, pa1, pa2, pa3); SBAR();                                                           \
        if ((t) + 1 < NT) { SLOAD_H(Kh, Vh, KBASE((t) + 1)); SBAR(); }                                               \
        pv_tile<VB>(o, vb0, pa0, pa1, pa2, pa3); MASKT(PX0, PX1, (t)); partialSM(PX0, PX1, m_reg, mnX, alX, KEEPT(t));                                        \
        __syncthreads();                                                                                                      \
        if ((t) + 1 < NT) { VMW(); SWRITE_H(SB); }                                                                          \
        RESC(alX); __syncthreads(); } while (0)
    for (int t = 1; t + 1 < NT; t += 2) {
        HALF_STEP(pB0, pB1, mnB, alB, pA0, pA1, alA, t, 1, 0, 0);
        HALF_STEP(pA0, pA1, mnA, alA, pB0, pB1, alB, t + 1, 0, 1, 1);
    }
    const bool even = (NT & 1) == 0;
    if (even) { SBAR(); qkt<1>(pB0, pB1, K_lds, r32, hi, S.qr); SBAR(); }
    SLOAD_H(BP.K + (size_t)nxt.kvo, BP.V + (size_t)nxt.kvo, 0); SBAR();
    int tz = threadIdx.x; asm volatile("" : "+v"(tz));
    const int widz = __builtin_amdgcn_readfirstlane(tz >> 6), r32z = tz & 31, hiz = (tz >> 5) & 1;
    { const bf16_t* qn = BP.Q + (size_t)nxt.qo + (size_t)(widz * QBLK + r32z) * LD + hiz * 8;
#pragma unroll
      for (int d0 = 0; d0 < 8; ++d0) S.qr[d0] = load8(qn + d0 * 16); }
    SBAR();
    finishSM(pA0, pA1, alA, l_reg, pa0, pa1, pa2, pa3); SBAR();
    pv_tile<0>(o, vb0, pa0, pa1, pa2, pa3);
    if (even) { MASKT(pB0, pB1, NT - 1); partialSM(pB0, pB1, m_reg, mnB, alB, KEEPT(NT - 1)); __syncthreads(); RESC(alB);
        finishSM(pB0, pB1, alB, l_reg, pa0, pa1, pa2, pa3); SBAR(); pv_tile<1>(o, vb0, pa0, pa1, pa2, pa3); }
    SBAR(); SEAM_K0();
    const bf16x8 gnext = GLOAD(nxt, tz);
    if (hiz == 0) li_l[r32z] = l_reg; asm volatile("s_waitcnt lgkmcnt(0)" ::: "memory");
    float rli[16];
#pragma unroll
    for (int r = 0; r < 16; ++r) rli[r] = __builtin_amdgcn_rcpf(li_l[crow(r, hiz)]);
#if FP8_OUT
    { const int lanez = tz & 63; char* ost = lds + LDS_ATT + widz * 4096;
#pragma unroll
      for (int r = 0; r < 16; ++r) { const int orow = (r & 3) + 8 * (r >> 2) + 4 * hiz; const float sc = rli[r] * YMIX_SC;
#pragma unroll
          for (int d0 = 0; d0 < 4; ++d0) { const float v = o[d0][r] * sc; *(unsigned char*)(ost + orow * 128 + d0 * 32 + r32z) = (unsigned char)__builtin_amdgcn_cvt_pk_fp8_f32(v, v, 0, false); } }
      asm volatile("s_waitcnt lgkmcnt(0)" ::: "memory");
      unsigned char* Og = (unsigned char*)BP.O + (size_t)cur.qo + (size_t)(widz * QBLK + (lanez >> 3)) * LD + (lanez & 7) * 16;
      u32x4 w4[4];
#pragma unroll
      for (int q4 = 0; q4 < 4; ++q4) w4[q4] = *(const u32x4*)(ost + ((lanez >> 3) + 8 * q4) * 128 + (lanez & 7) * 16);
#pragma unroll
      for (int q4 = 0; q4 < 4; ++q4) *(u32x4*)(Og + (size_t)(8 * q4) * LD) = w4[q4];
      asm volatile("s_waitcnt lgkmcnt(0)" ::: "memory"); }
#else
    bf16_t* Ow = BP.O + (size_t)cur.qo + (size_t)(widz * QBLK + 4 * hiz) * LD + r32z;
#pragma unroll
    for (int r = 0; r < 16; ++r) { const int orow = (r & 3) + 8 * (r >> 2);
#pragma unroll
        for (int d0 = 0; d0 < 4; ++d0) { const float v = o[d0][r] * rli[r];
            const float vn = __shfl_xor(v, 1);
            if ((r32z & 1) == 0) *(unsigned*)(Ow + (size_t)orow * LD + d0 * 32) = cvtpk(v, vn); } }
#endif
    GWRITE(gnext, tz);
    __syncthreads();
#undef RESC
#undef KBASE
#undef MASKT
#undef KEEPT
#undef SEAM_K0
#undef HALF_STEP
}
#undef ROW
#undef VMW
#undef VMWN
#undef SLOAD_H
#undef SWRITE_HK
#undef SWRITE_HV
#undef SWRITE_H
#undef GLOAD
#undef GWRITE

__device__ __forceinline__ bool item_of(int c, int G, int i, int& bh, int& x) {
    if (G == 256) { const int s = (c >> 3) + 32 * i; if (s >= 64) return false; bh = (c & 7) * 8 + (s >> 3); x = s & 7; return true; }
    const int L = c + i * G; if (L >= 512) return false; bh = L >> 3; x = L & 7; return true;
}
__device__ __forceinline__ BlockRef ref_of(int bh, int qb) {
    const int b = bh >> 3, h = bh & 7; BlockRef r;
    r.qo = (b * SEQ + qb * QB) * LD + h * HD; r.kvo = b * SEQ * LD + h * HD; r.kmo = b * 16 * LD + h * HD; r.qb = qb;
    return r;
}
__device__ __forceinline__ void attn_phase(char* lds, const Bases& BP, int G, int c) {
    int it = 0, bh, x; if (!item_of(c, G, 0, bh, x)) return;
    int pass = 0;
    BlockRef cur = ref_of(bh, x);
    Seam S;
    moba_prime(BP, cur, lds, S);
    for (;;) {
        int bhn = bh, xn = x, passn = pass + 1, itn = it; bool last = false;
        if (pass == 1) { passn = 0; itn = it + 1; if (!item_of(c, G, itn, bhn, xn)) { last = true; bhn = bh; xn = x; passn = pass; itn = it; } }
        const BlockRef nxt = last ? cur : ref_of(bhn, passn ? 15 - xn : xn);
        moba_block(BP, cur, nxt, lds, S);
        if (last) break;
        cur = nxt; bh = bhn; x = xn; pass = passn; it = itn;
    }
}
}

struct Args { const float* in[22]; float* out; unsigned char* ws; };

__device__ __forceinline__ int rowmap(int mode, int n) {
    if (mode == 1) { const int g = n >> 10, m = n & 1023; return ((m >> 7) << 8) + (g << 7) + (m & 127); }
    if (mode == 2) { if (n >= 2048) return n; const int d = n & 127, dd = d & 63; return (n & ~127) + ((dd >> 4) << 5) + (((dd >> 2) & 3) << 3) + ((d >> 6) << 2) + (d & 3); }
    return n;
}
struct CvItem { const float* W; bf16_t* WT; int N, ldk, koff, row_off, mode, kb, nb; float f8scale; };
__device__ __forceinline__ const float* arg_ptr(int k);
constexpr int CV_SMALL = 2 * 512 + 2 * 256 + 2 * 256 + 2 * 768 + 2 * 8 * 2 * 4;
constexpr int CV_MOE = 32 * 512 + 32 * 256;
__device__ __forceinline__ CvItem cv_small(unsigned char* ws, int r) {
    CvItem c; c.ldk = 1024; c.koff = 0; c.row_off = 0; c.mode = 0; c.f8scale = 0.f;
    constexpr int I_IN = 2 * 512, I_OUTR = 2 * 256, I_O = 2 * 256, I_QKV = 2 * 768;
    if (r < I_IN) { const int mat = r >> 9, rr = r & 511; c.W = arg_ptr(5) + (size_t)mat * 1024 * 2048; c.N = 2048; c.WT = (bf16_t*)(ws + WS_WIN) + (size_t)mat * 2048 * 1024; c.kb = rr >> 6; c.nb = rr & 63; if (FP8_IN) { c.f8scale = 32.0f; c.WT = (bf16_t*)(ws + WS_WIN + (size_t)mat * 2048 * 1024); } }
    else if ((r -= I_IN) < I_OUTR) { const int mat = r >> 8, rr = r & 255; c.W = arg_ptr(13) + (size_t)mat * 1024 * 1024; c.N = 1024; c.WT = (bf16_t*)(ws + WS_WOUT) + (size_t)(2 * mat) * 1024 * 1024; c.kb = rr >> 5; c.nb = rr & 31; if (FP8_OUT) { c.f8scale = 32.0f; c.WT = (bf16_t*)(ws + WS_WOUT + (size_t)(2 * mat) * 1024 * 1024); } }
    else if ((r -= I_OUTR) < I_O) { const int mat = r >> 8, rr = r & 255; c.W = arg_ptr(15) + (size_t)mat * 1024 * 1024; c.N = 1024; c.WT = (bf16_t*)(ws + WS_WOUT) + (size_t)(2 * mat + 1) * 1024 * 1024; c.kb = rr >> 5; c.nb = rr & 31; if (FP8_OUT) { c.f8scale = 32.0f; c.WT = (bf16_t*)(ws + WS_WOUT + (size_t)(2 * mat + 1) * 1024 * 1024); } }
    else if ((r -= I_O) < I_QKV) { const int mat = r / 768, rr = r % 768; c.W = arg_ptr(14) + (size_t)mat * 1024 * 3072; c.N = 3072; c.WT = (bf16_t*)(ws + WS_WQKV) + (size_t)mat * 3072 * 1024; c.kb = rr / 96; c.nb = rr % 96; c.mode = 2; if (FP8_QKV) { c.f8scale = 32.0f; c.WT = (bf16_t*)(ws + WS_WQKV + (size_t)mat * 3072 * 1024); } }
    else { r -= I_QKV; const int rr = r & 3, m2 = r >> 2, which = m2 & 1, h = (m2 >> 1) & 7, l = m2 >> 4;
        c.W = arg_ptr(which ? 10 : 8) + (size_t)(l * 8 + h) * 128 * 128; c.N = 128; c.WT = (bf16_t*)(ws + WS_WGATE) + (size_t)(l * 8 + h) * 256 * 128; c.ldk = 128; c.row_off = 128 * which; c.kb = 0; c.nb = rr; }
    return c;
}
__device__ __forceinline__ CvItem cv_moe(unsigned char* ws, int layer, int r) {
    CvItem c; c.ldk = 1024; c.koff = 0; c.row_off = 0; c.f8scale = 0.f;
    if (r < 32 * 512) { const int mat = layer * 32 + (r >> 9), rr = r & 511; c.W = arg_ptr(18) + (size_t)mat * 1024 * 2048; c.N = 2048; c.WT = (bf16_t*)(ws + WS_WGU) + (size_t)mat * 2048 * 1024; c.kb = rr >> 6; c.nb = rr & 63; c.mode = 1; if (FP8_GU) { c.f8scale = 32.0f; c.WT = (bf16_t*)(ws + WS_WGU + (size_t)mat * 2048 * 1024); } }
    else { r -= 32 * 512; const int mat = layer * 32 + (r >> 8), rr = r & 255; c.W = arg_ptr(20) + (size_t)mat * 1024 * 1024; c.N = 1024; c.WT = (bf16_t*)(ws + WS_WDN) + (size_t)mat * 1024 * 1024; c.kb = rr >> 5; c.nb = rr & 31; c.mode = 0; if (FP8_DN) { c.f8scale = 64.0f; c.WT = (bf16_t*)(ws + WS_WDN + (size_t)mat * 1024 * 1024); } }
    return c;
}
__device__ __forceinline__ void cv_load(const CvItem& c, int lane, f32x4 (&v)[16]) {
    const float* ub = c.W + (size_t)(128 * c.kb) * c.N + 32 * c.nb;
    const unsigned lo = ((unsigned)(lane >> 3) * (unsigned)c.N + 4u * (lane & 7)) * 4u;
#pragma unroll
    for (int i = 0; i < 16; ++i) v[i] = __builtin_nontemporal_load((const f32x4*)((const char*)(ub + (size_t)(8 * i) * c.N) + lo));
}
__device__ __forceinline__ void cv_put(int lane, const f32x4 (&v)[16], LAS float* scr) {
#pragma unroll
    for (int i = 0; i < 16; ++i) { LAS float* d = scr + i * 266 + (lane >> 3) * 33 + 4 * (lane & 7); d[0] = v[i][0]; d[1] = v[i][1]; d[2] = v[i][2]; d[3] = v[i][3]; }
    LDS_WAIT(); asm volatile("" ::: "memory");
}
__device__ __forceinline__ void cv_emit(const CvItem& c, int lane, LAS float* scr) {
    const int cc = lane & 15;
#pragma unroll
    for (int j = 0; j < 8; ++j) { const int n = (lane >> 4) + 4 * j; const LAS float* s = scr + cc * 266 + n;
        const unsigned eo = (unsigned)rowmap(c.mode, 32 * c.nb + n) * (unsigned)c.ldk + 8u * cc;
        if (c.f8scale != 0.f) { const float q = c.f8scale; u32x2 o; o.x = pk4_fp8(s[0 * 33] * q, s[1 * 33] * q, s[2 * 33] * q, s[3 * 33] * q); o.y = pk4_fp8(s[4 * 33] * q, s[5 * 33] * q, s[6 * 33] * q, s[7 * 33] * q);
            *(u32x2*)((unsigned char*)c.WT + ((size_t)c.row_off * c.ldk + c.koff + 128 * c.kb) + eo) = o; }
        else { u32x4 o; o.x = pk2(s[0 * 33], s[1 * 33]); o.y = pk2(s[2 * 33], s[3 * 33]); o.z = pk2(s[4 * 33], s[5 * 33]); o.w = pk2(s[6 * 33], s[7 * 33]);
            *(u32x4*)((unsigned char*)(c.WT + ((size_t)c.row_off * c.ldk + c.koff + 128 * c.kb)) + 2u * eo) = o; } }
    LDS_WAIT(); asm volatile("" ::: "memory");
}
__device__ __forceinline__ void cv_store(const CvItem& c, int lane, const f32x4 (&v)[16], LAS float* scr) { cv_put(lane, v, scr); cv_emit(c, lane, scr); }
__device__ __forceinline__ void cv8_cvt(float q, const f32x4 (&v)[16], unsigned (&w)[16]) {
#pragma unroll
    for (int i = 0; i < 16; ++i) { const f32x4 t = v[i] * q; w[i] = pk4_fp8(t[0], t[1], t[2], t[3]); }
}
__device__ __forceinline__ void cv8_put(int lane, const unsigned (&w)[16], LAS unsigned* scr) {
    LAS unsigned* d = scr + 32 * (lane >> 5) + 4 * (lane & 7) + ((lane >> 3) & 3);
#pragma unroll
    for (int i = 0; i < 16; ++i) d[160 * (i >> 1) + 64 * (i & 1)] = w[i];
    LDS_WAIT(); asm volatile("" ::: "memory");
}
__device__ __forceinline__ void cv8_emit(const CvItem& c, int lane, LAS unsigned* scr) {
    const int ng = lane & 7, kgg = lane >> 3;
    u32x4 r[4];
#pragma unroll
    for (int t = 0; t < 4; ++t) r[t] = *(const LAS u32x4*)(scr + 160 * kgg + 32 * t + 4 * ng);
    LDS_WAIT(); asm volatile("" ::: "memory");
    u32x4 o[4];
#pragma unroll
    for (int t = 0; t < 4; ++t) {
        const unsigned t0 = __builtin_amdgcn_perm(r[t][1], r[t][0], 0x05010400u), t1 = __builtin_amdgcn_perm(r[t][1], r[t][0], 0x07030602u);
        const unsigned t2 = __builtin_amdgcn_perm(r[t][3], r[t][2], 0x05010400u), t3 = __builtin_amdgcn_perm(r[t][3], r[t][2], 0x07030602u);
        o[0][t] = __builtin_amdgcn_perm(t2, t0, 0x05040100u); o[1][t] = __builtin_amdgcn_perm(t2, t0, 0x07060302u);
        o[2][t] = __builtin_amdgcn_perm(t3, t1, 0x05040100u); o[3][t] = __builtin_amdgcn_perm(t3, t1, 0x07060302u); }
    unsigned char* wb = (unsigned char*)c.WT + ((size_t)c.row_off * c.ldk + c.koff + 128 * c.kb);
#pragma unroll
    for (int j = 0; j < 4; ++j) { const unsigned eo = (unsigned)rowmap(c.mode, 32 * c.nb + 4 * ng + j) * (unsigned)c.ldk + 16u * kgg;
        *(u32x4*)(wb + eo) = o[j]; }
}
__device__ __forceinline__ void cv_moe_range(unsigned char* ws, LAS unsigned char* lds, int layer, int lo, int hi, int G, int wg = -1) {
    const int tid = opaque_tid(), lane = tid & 63, wave = __builtin_amdgcn_readfirstlane(tid >> 6);
    const int gw = (wg < 0 ? (int)blockIdx.x : wg) * 8 + wave, NGW = G * 8;
    int it = lo + gw; if (it >= hi) return;
    f32x4 vA[16], vB[16]; CvItem cA, cB, cE;
#define CV_LD(c, v, idx) do { const int i_ = (idx); const bool h_ = i_ < hi; c = cv_moe(ws, layer, h_ ? i_ : it); if (h_) cv_load(c, lane, v); } while (0)
    CV_LD(cA, vA, it); CV_LD(cB, vB, it + NGW);
#if FP8_GU && FP8_DN
    LAS unsigned* scr = (LAS unsigned*)(lds + wave * CV_SCR);
    unsigned w[16];
    for (;;) {
        cv8_cvt(cA.f8scale, vA, w); cE = cA; CV_LD(cA, vA, it + 2 * NGW); cv8_put(lane, w, scr); cv8_emit(cE, lane, scr); if (it + NGW >= hi) break;
        cv8_cvt(cB.f8scale, vB, w); cE = cB; CV_LD(cB, vB, it + 3 * NGW); cv8_put(lane, w, scr); cv8_emit(cE, lane, scr); if (it + 2 * NGW >= hi) break;
        it += 2 * NGW;
    }
#else
    LAS float* scr = (LAS float*)(lds + wave * CV_SCR);
    for (;;) {
        cv_put(lane, vA, scr); cE = cA; CV_LD(cA, vA, it + 2 * NGW); cv_emit(cE, lane, scr); if (it + NGW >= hi) break;
        cv_put(lane, vB, scr); cE = cB; CV_LD(cB, vB, it + 3 * NGW); cv_emit(cE, lane, scr); if (it + 2 * NGW >= hi) break;
        it += 2 * NGW;
    }
#endif
#undef CV_LD
}
__device__ __forceinline__ void cv_idle_slot(unsigned char* ws, LAS unsigned char* lds, int layer, int quota) {
    if (layer >= DEPTH) return;
    const int tid = opaque_tid(), lane = tid & 63, wave = __builtin_amdgcn_readfirstlane(tid >> 6);
    LAS float* scr = (LAS float*)(lds + wave * CV_SCR);
    unsigned* ctr = (unsigned*)(ws + WS_CTL) + 8192 + 64 * layer;
    for (int q = 0; q < quota; ++q) {
        unsigned it = 0; if (lane == 0) it = __hip_atomic_fetch_add(ctr, 2u, __ATOMIC_RELAXED, __HIP_MEMORY_SCOPE_AGENT);
        it = (unsigned)__builtin_amdgcn_readfirstlane((int)it);
        if (it >= (unsigned)CV_MOE) break;
        const CvItem c0 = cv_moe(ws, layer, (int)it), c1 = cv_moe(ws, layer, (int)it + 1);
        f32x4 v0[16], v1[16]; cv_load(c0, lane, v0); cv_load(c1, lane, v1);
        cv_store(c0, lane, v0, scr); cv_store(c1, lane, v1, scr);
    }
}
__device__ __forceinline__ void cv_cleanup(unsigned char* ws, LAS unsigned char* lds, int layer, int G) {
    unsigned done = __hip_atomic_load((unsigned*)(ws + WS_CTL) + 8192 + 64 * layer, __ATOMIC_RELAXED, __HIP_MEMORY_SCOPE_AGENT);
    done = (unsigned)__builtin_amdgcn_readfirstlane((int)done);
    if (done < (unsigned)CV_MOE) cv_moe_range(ws, lds, layer, (int)done, CV_MOE, G);
}

__device__ __forceinline__ void prologue_phase(LAS unsigned char* lds, int G) {
    unsigned char* ws = (unsigned char*)arg_ptr(23);
    const int tid = opaque_tid(), lane = tid & 63, wave = __builtin_amdgcn_readfirstlane(tid >> 6);
    LAS float* scr = (LAS float*)(lds + wave * CV_SCR);
    const int gw = blockIdx.x * 8 + wave, NGW = G * 8;
    for (int it = gw; it < CV_SMALL; it += NGW) { const CvItem c = cv_small(ws, it); f32x4 v[16]; cv_load(c, lane, v); cv_store(c, lane, v, scr); }
    cv_moe_range(ws, lds, 0, 0, CV_MOE, G);
    const size_t gt = (size_t)blockIdx.x * 512 + tid, NGT = (size_t)G * 512;
    { int4* rt4 = (int4*)(ws + WS_ROWTOK); for (size_t i = gt; i < (size_t)NE * RT_CAP / 4; i += NGT) rt4[i] = make_int4(0, 0, 0, 0); }
    const float* x = arg_ptr(0); bf16_t* xb = (bf16_t*)(ws + WS_XBF);
    for (size_t i0 = gt; i0 < (size_t)T * D / 8; i0 += 4 * NGT) { f32x4 v0[4], v1[4];
#pragma unroll
        for (int u = 0; u < 4; ++u) { const size_t i = i0 + u * NGT; if (i < (size_t)T * D / 8) { v0[u] = *(const f32x4*)(x + i * 8); v1[u] = *(const f32x4*)(x + i * 8 + 4); } }
#pragma unroll
        for (int u = 0; u < 4; ++u) { const size_t i = i0 + u * NGT; if (i < (size_t)T * D / 8) { u32x4 w; w.x = pk2(v0[u][0], v0[u][1]); w.y = pk2(v0[u][2], v0[u][3]); w.z = pk2(v1[u][0], v1[u][1]); w.w = pk2(v1[u][2], v1[u][3]); *(u32x4*)(xb + i * 8) = w;
            if (FP8_X) { u32x2 q; q.x = pk4_fp8(v0[u][0], v0[u][1], v0[u][2], v0[u][3]); q.y = pk4_fp8(v1[u][0], v1[u][1], v1[u][2], v1[u][3]); *(u32x2*)(ws + WS_XF8 + i * 8) = q; } } } }
}

__device__ __forceinline__ void conv_phase(const bf16_t* rec, bf16_t* ub, const float* cw, const float* cb, int G) {
    const int tid = opaque_tid(), cg = tid & 127, rs = tid >> 7;
    float w[4][8], bias[8];
#pragma unroll
    for (int j = 0; j < 4; ++j) { const f32x4 a0 = *(const f32x4*)(cw + j * D + cg * 8), a1 = *(const f32x4*)(cw + j * D + cg * 8 + 4);
#pragma unroll
        for (int e = 0; e < 4; ++e) { w[j][e] = a0[e]; w[j][4 + e] = a1[e]; } }
    { const f32x4 a0 = *(const f32x4*)(cb + cg * 8), a1 = *(const f32x4*)(cb + cg * 8 + 4);
#pragma unroll
      for (int e = 0; e < 4; ++e) { bias[e] = a0[e]; bias[4 + e] = a1[e]; } }
    for (int ti_ = blockIdx.x; ti_ < T / 128; ti_ += G) { const int tile = (G == 256) ? ((ti_ & 7) * 32 + (ti_ >> 3)) : ti_;
        const int t0 = tile * 128 + rs * 32; const bool seq_start = (t0 & (SEQ - 1)) == 0;
        float p[3][8];
#pragma unroll
        for (int k = 0; k < 3; ++k) { u32x4 v = (u32x4){0u, 0u, 0u, 0u}; if (!seq_start) v = *(const u32x4*)(rec + (size_t)(t0 - 3 + k) * D + cg * 8);
            p[k][0] = bflo(v.x); p[k][1] = bfhi(v.x); p[k][2] = bflo(v.y); p[k][3] = bfhi(v.y); p[k][4] = bflo(v.z); p[k][5] = bfhi(v.z); p[k][6] = bflo(v.w); p[k][7] = bfhi(v.w); }
        for (int r0 = 0; r0 < 32; r0 += 8) { u32x4 vin[8];
#pragma unroll
          for (int rr = 0; rr < 8; ++rr) vin[rr] = *(const u32x4*)(rec + (size_t)(t0 + r0 + rr) * D + cg * 8);
#pragma unroll
          for (int rr = 0; rr < 8; ++rr) { const int r = r0 + rr; const u32x4 v = vin[rr];
            float c[8] = {bflo(v.x), bfhi(v.x), bflo(v.y), bfhi(v.y), bflo(v.z), bfhi(v.z), bflo(v.w), bfhi(v.w)}; float o[8];
#pragma unroll
            for (int e = 0; e < 8; ++e) { o[e] = bias[e] + w[0][e] * p[0][e] + w[1][e] * p[1][e] + w[2][e] * p[2][e] + w[3][e] * c[e]; p[0][e] = p[1][e]; p[1][e] = p[2][e]; p[2][e] = c[e]; }
            u32x4 ow; ow.x = pk2(o[0], o[1]); ow.y = pk2(o[2], o[3]); ow.z = pk2(o[4], o[5]); ow.w = pk2(o[6], o[7]);
            *(u32x4*)(ub + (size_t)(t0 + r) * D + cg * 8) = ow; } }
    }
}

__device__ __forceinline__ void scan1_phase(const bf16_t* la, const bf16_t* bb, float* agg, int G) {
    const int tid = opaque_tid();
    for (int un_ = blockIdx.x; un_ < 256; un_ += G) { const int unit = (G == 256) ? ((un_ & 7) * 32 + (un_ >> 3)) : un_;
        const size_t base = (size_t)unit * 128 * D + 2 * tid;
        float h0 = 0.f, h1 = 0.f, s0 = 0.f, s1 = 0.f;
        for (int t0 = 0; t0 < 128; t0 += 32) { unsigned lw[32], bw[32];
#pragma unroll
            for (int t = 0; t < 32; ++t) { lw[t] = *(const unsigned*)(la + base + (size_t)(t0 + t) * D); bw[t] = FP8_SCAN ? (unsigned)*(const unsigned short*)((const unsigned char*)bb + base + (size_t)(t0 + t) * D) : *(const unsigned*)(bb + base + (size_t)(t0 + t) * D); }
#pragma unroll
            for (int t = 0; t < 32; ++t) { const float l0 = bflo(lw[t]), l1 = bfhi(lw[t]); float b0, b1;
                if (FP8_SCAN) { const f32x2 b2 = __builtin_amdgcn_cvt_pk_f32_fp8((int)bw[t], false); b0 = b2[0]; b1 = b2[1]; } else { b0 = bflo(bw[t]); b1 = bfhi(bw[t]); }
                h0 = __expf(l0) * h0 + b0; h1 = __expf(l1) * h1 + b1; s0 += l0; s1 += l1; } }
        *(f32x4*)(agg + ((size_t)unit * D + 2 * tid) * 2) = (f32x4){__expf(s0), h0, __expf(s1), h1};
    }
}
__device__ __forceinline__ void scan2_phase(const bf16_t* la, const bf16_t* bb, const float* agg, const bf16_t* gg, bf16_t* y, int G) {
    const int tid = opaque_tid();
    for (int un_ = blockIdx.x; un_ < 256; un_ += G) { const int unit = (G == 256) ? ((un_ & 7) * 32 + (un_ >> 3)) : un_;
        const int chunk = unit & 31; const size_t base = (size_t)unit * 128 * D + 2 * tid;
        float h0 = 0.f, h1 = 0.f;
        const float* ag = agg + ((size_t)(unit - chunk) * D + 2 * tid) * 2;
#pragma unroll 8
        for (int jc = 0; jc < chunk; ++jc) { const f32x4 a = *(const f32x4*)(ag + (size_t)jc * D * 2); h0 = a[0] * h0 + a[1]; h1 = a[2] * h1 + a[3]; }
        for (int t0 = 0; t0 < 128; t0 += 16) { unsigned lw[16], bw[16], gw[16];
#pragma unroll
            for (int t = 0; t < 16; ++t) { lw[t] = *(const unsigned*)(la + base + (size_t)(t0 + t) * D);
                if (FP8_SCAN) { bw[t] = *(const unsigned short*)((const unsigned char*)bb + base + (size_t)(t0 + t) * D); gw[t] = *(const unsigned short*)((const unsigned char*)gg + base + (size_t)(t0 + t) * D); }
                else { bw[t] = *(const unsigned*)(bb + base + (size_t)(t0 + t) * D); gw[t] = *(const unsigned*)(gg + base + (size_t)(t0 + t) * D); } }
#pragma unroll
            for (int t = 0; t < 16; ++t) {
#if FP8_SCAN
                { const f32x2 b2 = __builtin_amdgcn_cvt_pk_f32_fp8((int)bw[t], false), g2 = __builtin_amdgcn_cvt_pk_f32_fp8((int)gw[t], false);
                  h0 = __expf(bflo(lw[t])) * h0 + b2[0]; h1 = __expf(bfhi(lw[t])) * h1 + b2[1];
                  *(unsigned short*)((unsigned char*)y + base + (size_t)(t0 + t) * D) = (unsigned short)__builtin_amdgcn_cvt_pk_fp8_f32(h0 * g2[0] * (YMIX_SC / (SCAN_SC * SCAN_SC)), h1 * g2[1] * (YMIX_SC / (SCAN_SC * SCAN_SC)), 0, false); }
                continue;
#endif
                h0 = __expf(bflo(lw[t])) * h0 + bflo(bw[t]); h1 = __expf(bfhi(lw[t])) * h1 + bfhi(bw[t]);
                if (FP8_OUT) *(unsigned short*)((unsigned char*)y + base + (size_t)(t0 + t) * D) = (unsigned short)__builtin_amdgcn_cvt_pk_fp8_f32(h0 * bflo(gw[t]) * YMIX_SC, h1 * bfhi(gw[t]) * YMIX_SC, 0, false);
                else *(unsigned*)(y + base + (size_t)(t0 + t) * D) = pk2(h0 * bflo(gw[t]), h1 * bfhi(gw[t])); } }
    }
}

__device__ __forceinline__ float half_max_fast(float v) {
    v = fmaxf(v, dppf<0xB1>(v)); v = fmaxf(v, dppf<0x4E>(v)); v = fmaxf(v, dppf<0x141>(v)); v = fmaxf(v, dppf<0x140>(v));
    { auto r = __builtin_amdgcn_permlane16_swap(__float_as_uint(v), __float_as_uint(v), false, false); v = fmaxf(__uint_as_float(r[0]), __uint_as_float(r[1])); }
    return v;
}
__device__ __forceinline__ void ln1_router_mfma_phase(LAS unsigned char* lds, const bf16_t* z, const float* g1, const float* b1, const float* wrt, const float* brt,
                                                      float* stats, unsigned char* x1f8, float* tokg, unsigned* gcnt, int* row_tok, int* pos_out, int G) {
    const int tid = opaque_tid(), lane = tid & 63, wave = __builtin_amdgcn_readfirstlane(tid >> 6);
    constexpr int RS = 2064;
    LAS unsigned char* XH = lds; LAS unsigned char* XL = lds + 16 * RS; LAS float* PART = (LAS float*)(lds + 32 * RS);
    LAS int* hist = (LAS int*)(lds + MISC_HIST);
    LAS int* tokl = (LAS int*)(lds + 32 * RS + 16896); LAS int* sBase = tokl + 512; LAS int* wcnt = sBase + 32;
    bf16x8 Bh[4][2], Bl[4][2];
    { const int n = lane & 15, kg = lane >> 4;
#pragma unroll
      for (int c = 0; c < 4; ++c)
#pragma unroll
          for (int h = 0; h < 2; ++h) { float wv[8];
#pragma unroll
              for (int j = 0; j < 8; ++j) wv[j] = wrt[(size_t)(128 * wave + 32 * c + 8 * kg + j) * NE + 16 * h + n];
#pragma unroll
              for (int j = 0; j < 8; ++j) { const unsigned hb = f2bf(wv[j]); Bh[c][h][j] = (short)hb; Bl[c][h][j] = (short)f2bf(wv[j] - __uint_as_float(hb << 16)); } } }
    f32x4 gv[4], bv[4];
#pragma unroll
    for (int i = 0; i < 4; ++i) { gv[i] = *(const f32x4*)(g1 + 4 * lane + 256 * i); bv[i] = *(const f32x4*)(b1 + 4 * lane + 256 * i); }
    const float bias_e = brt[lane & 31];
    for (int ti_ = blockIdx.x; ti_ < T / 128; ti_ += G) { const int tile = (G == 256) ? ((ti_ & 7) * 32 + (ti_ >> 3)) : ti_;
        if (tid < 32) hist[tid] = 0;
        __syncthreads();
        const int rb = tile * 128 + 2 * wave;
        u32x2 nv[2][4];
#pragma unroll
        for (int q = 0; q < 2; ++q)
#pragma unroll
            for (int i = 0; i < 4; ++i) nv[q][i] = *(const u32x2*)(z + (size_t)(rb + q) * D + 4 * lane + 256 * i);
        for (int st = 0; st < 8; ++st) {
            f32x4 v[2][4];
#pragma unroll
            for (int q = 0; q < 2; ++q)
#pragma unroll
                for (int i = 0; i < 4; ++i) v[q][i] = (f32x4){bflo(nv[q][i].x), bfhi(nv[q][i].x), bflo(nv[q][i].y), bfhi(nv[q][i].y)};
            { const int sn = (st < 7 ? st + 1 : st);
#pragma unroll
              for (int q = 0; q < 2; ++q)
#pragma unroll
                  for (int i = 0; i < 4; ++i) nv[q][i] = *(const u32x2*)(z + (size_t)(rb + 16 * sn + q) * D + 4 * lane + 256 * i); }
#pragma unroll
            for (int q = 0; q < 2; ++q) { const int row = rb + 16 * st + q; float s = 0.f;
#pragma unroll
                for (int i = 0; i < 4; ++i) s += (v[q][i][0] + v[q][i][1]) + (v[q][i][2] + v[q][i][3]);
                const float mean = wave_sum_fast(s) * (1.0f / D); float qq = 0.f;
#pragma unroll
                for (int i = 0; i < 4; ++i) { v[q][i] = v[q][i] - mean; qq += (v[q][i][0] * v[q][i][0] + v[q][i][1] * v[q][i][1]) + (v[q][i][2] * v[q][i][2] + v[q][i][3] * v[q][i][3]); }
                const float rstd = 1.0f / sqrtf(wave_sum_fast(qq) * (1.0f / D) + LN_EPS);
                if (lane == 0) *(f32x2*)(stats + (size_t)row * 2) = (f32x2){mean, rstd};
                LAS unsigned char* xh = XH + (2 * wave + q) * RS + 8 * lane; LAS unsigned char* xl = XL + (2 * wave + q) * RS + 8 * lane;
#pragma unroll
                for (int i = 0; i < 4; ++i) { v[q][i] = v[q][i] * rstd * gv[i] + bv[i];
                    *(unsigned*)(x1f8 + (size_t)row * D + 4 * lane + 256 * i) = pk4_fp8(v[q][i][0], v[q][i][1], v[q][i][2], v[q][i][3]);
                    u32x2 hw; hw.x = cvt_pk_bf16(v[q][i][0], v[q][i][1]); hw.y = cvt_pk_bf16(v[q][i][2], v[q][i][3]);
                    u32x2 lw; lw.x = cvt_pk_bf16(v[q][i][0] - __uint_as_float(hw.x << 16), v[q][i][1] - __uint_as_float(hw.x & 0xffff0000u));
                    lw.y = cvt_pk_bf16(v[q][i][2] - __uint_as_float(hw.y << 16), v[q][i][3] - __uint_as_float(hw.y & 0xffff0000u));
                    *(LAS u32x2*)(xh + 512 * i) = hw; *(LAS u32x2*)(xl + 512 * i) = lw; } }
            __syncthreads();
            f32x4 acc[2] = {(f32x4){0.f, 0.f, 0.f, 0.f}, (f32x4){0.f, 0.f, 0.f, 0.f}};
            { const int aoff = (lane & 15) * RS + (128 * wave + 8 * (lane >> 4)) * 2;
#pragma unroll
              for (int c = 0; c < 4; ++c) { const bf16x8 ah = *(const LAS bf16x8*)(XH + aoff + 64 * c), al = *(const LAS bf16x8*)(XL + aoff + 64 * c);
#pragma unroll
                  for (int h = 0; h < 2; ++h) { acc[h] = __builtin_amdgcn_mfma_f32_16x16x32_bf16(ah, Bh[c][h], acc[h], 0, 0, 0);
                      acc[h] = __builtin_amdgcn_mfma_f32_16x16x32_bf16(al, Bh[c][h], acc[h], 0, 0, 0); acc[h] = __builtin_amdgcn_mfma_f32_16x16x32_bf16(ah, Bl[c][h], acc[h], 0, 0, 0); } } }
#pragma unroll
            for (int h = 0; h < 2; ++h)
#pragma unroll
                for (int r = 0; r < 4; ++r) PART[(wave * 16 + 4 * (lane >> 4) + r) * 33 + 16 * h + (lane & 15)] = acc[h][r];
            __syncthreads();
            float lv = bias_e;
#pragma unroll
            for (int w2 = 0; w2 < 8; ++w2) lv += PART[(w2 * 16 + 2 * wave + (lane >> 5)) * 33 + (lane & 31)];
            float tv[4]; int ti[4];
#pragma unroll
            for (int k = 0; k < 4; ++k) { const float m = half_max_fast(lv); const unsigned long long bl = __ballot(lv == m);
                const int i0 = __ffs((int)(unsigned)bl) - 1, i1 = __ffs((int)(unsigned)(bl >> 32)) - 1; const int idx = (lane >> 5) ? i1 : i0;
                tv[k] = m; ti[k] = idx; if ((lane & 31) == idx) lv = -__builtin_inff(); }
            if ((lane & 31) == 0) { const int row = rb + 16 * st + (lane >> 5);
                const float e1 = __expf(tv[1] - tv[0]), e2 = __expf(tv[2] - tv[0]), e3 = __expf(tv[3] - tv[0]); const float inv = 1.0f / (1.0f + e1 + e2 + e3);
                *(LAS v4i_t*)(tokl + (16 * st + 2 * wave + (lane >> 5)) * 4) = (v4i_t){ti[0], ti[1], ti[2], ti[3]};
                *(f32x4*)(tokg + (size_t)row * 4) = (f32x4){inv, e1 * inv, e2 * inv, e3 * inv};
#pragma unroll
                for (int k = 0; k < 4; ++k) __hip_atomic_fetch_add(hist + ti[k], 1, __ATOMIC_RELAXED, __HIP_MEMORY_SCOPE_WORKGROUP); }
        }
        __syncthreads();
        if (tid < 32) sBase[tid] = (int)__hip_atomic_fetch_add(gcnt + tid, (unsigned)hist[tid], __ATOMIC_RELAXED, __HIP_MEMORY_SCOPE_AGENT);
        { const int token = tile * 128 + (tid >> 2), k = tid & 3; const int e = tokl[tid];
          int myrank = 0;
          for (int ee = 0; ee < 32; ++ee) { const unsigned long long m = __ballot(e == ee); if (e == ee) myrank = __popcll(m & ((1ull << lane) - 1ull)); if (lane == 0) wcnt[ee * 8 + wave] = __popcll(m); }
          __syncthreads();
          int wpre = 0;
          for (int w = 0; w < wave; ++w) wpre += wcnt[e * 8 + w];
          const int slot = sBase[e] + wpre + myrank;
          row_tok[e * RT_CAP + slot] = token; pos_out[(size_t)token * 4 + k] = (e << 20) | slot; }
        __syncthreads();
    }
}

__device__ __forceinline__ void build_tfirst(LAS int* tfirst, const unsigned* gcnt) {
    const int tid = opaque_tid();
    if (tid < 64) { const int c = (tid < 32) ? (int)gcnt[tid] : 0; const int tiles = (c + 255) >> 8; int incl = tiles;
#pragma unroll
        for (int off = 1; off < 32; off <<= 1) { const int n = __shfl_up(incl, off); if (tid >= off) incl += n; }
        if (tid < 32) tfirst[tid] = incl - tiles; if (tid == 31) tfirst[32] = incl; }
    __syncthreads();
}
__device__ __forceinline__ int build_tile_e(LAS unsigned char* tile_e, LAS int* tfirst, const unsigned* gcnt) {
    build_tfirst(tfirst, gcnt);
    const int tid = opaque_tid(); const int n_rt = tfirst[32];
    for (int rt = tid; rt < n_rt; rt += 512) { int e = 0; for (int q = 1; q < 32; ++q) e += (rt >= tfirst[q]) ? 1 : 0; tile_e[rt] = (unsigned char)e; }
    __syncthreads();
    return n_rt;
}

__device__ __forceinline__ void combine_ln2_phase(const bf16_t* x1b, const void* ybv, const int* pos_out, const float* tokg, const float* g2, const float* b2, float* outf, bf16_t* outb, unsigned char* outf8, int G,
                                                  const bf16_t* zb, const float* g1, const float* b1, LAS unsigned char* lds, const unsigned* gcnt) {
    const int tid = opaque_tid(), lane = tid & 63, wave = __builtin_amdgcn_readfirstlane(tid >> 6);
    LAS int* tfirst = (LAS int*)lds; build_tfirst(tfirst, gcnt);
    f32x4 gv[4], bv[4], g1v[4], b1v[4];
#pragma unroll
    for (int i = 0; i < 4; ++i) { gv[i] = *(const f32x4*)(g2 + 16 * lane + 4 * i); bv[i] = *(const f32x4*)(b2 + 16 * lane + 4 * i);
        g1v[i] = *(const f32x4*)(g1 + 16 * lane + 4 * i) * ALPHA; b1v[i] = *(const f32x4*)(b1 + 16 * lane + 4 * i) * ALPHA; }
    static_assert(X1_RECOMPUTE && Y_F8, "this combine reads the bf16 z + LayerNorm1 statistics and fp8 expert outputs");
    const unsigned char* yb = (const unsigned char*)ybv;
    const bool xal = (G == 256);
    const int first = xal ? ((int)(blockIdx.x & 7) * SEQ + (int)(blockIdx.x >> 3) * 128 + wave * 16) : (int)blockIdx.x * 8 + wave, stride = xal ? 1 : G * 8, lim = xal ? first + 16 : T;
    for (int base = first; base < lim; base += stride * 64) {
        int nrow = (lim - base + stride - 1) / stride; if (nrow > 64) nrow = 64;
        int4 ps = make_int4(0, 0, 0, 0); f32x4 gt = (f32x4){0.f, 0.f, 0.f, 0.f}; f32x2 st = (f32x2){0.f, 0.f};
        if (lane < nrow) { const size_t rw = (size_t)(base + lane * stride); ps = *(const int4*)(pos_out + rw * 4);
            ps.x = (tfirst[ps.x >> 20] << 8) + (ps.x & 0xFFFFF); ps.y = (tfirst[ps.y >> 20] << 8) + (ps.y & 0xFFFFF); ps.z = (tfirst[ps.z >> 20] << 8) + (ps.z & 0xFFFFF); ps.w = (tfirst[ps.w >> 20] << 8) + (ps.w & 0xFFFFF);
            gt = *(const f32x4*)(tokg + rw * 4); st = *(const f32x2*)((const float*)x1b + rw * 2); }
        u32x4 nz[2], ny[4];
#define CMB_LOAD(i_) do { const int row_ = base + (i_) * stride; \
            const int p0_ = __builtin_amdgcn_readlane(ps.x, (i_)), p1_ = __builtin_amdgcn_readlane(ps.y, (i_)), p2_ = __builtin_amdgcn_readlane(ps.z, (i_)), p3_ = __builtin_amdgcn_readlane(ps.w, (i_)); \
            nz[0] = *(const u32x4*)(zb + (size_t)row_ * D + 16 * lane); nz[1] = *(const u32x4*)(zb + (size_t)row_ * D + 16 * lane + 8); \
            ny[0] = *(const u32x4*)(yb + (size_t)p0_ * D + 16 * lane); ny[1] = *(const u32x4*)(yb + (size_t)p1_ * D + 16 * lane); \
            ny[2] = *(const u32x4*)(yb + (size_t)p2_ * D + 16 * lane); ny[3] = *(const u32x4*)(yb + (size_t)p3_ * D + 16 * lane); } while (0)
        CMB_LOAD(0);
        for (int it = 0; it < nrow; ++it) {
            const int row = base + it * stride;
            const float g0 = __uint_as_float(__builtin_amdgcn_readlane(__float_as_uint(gt[0]), it)), g1_ = __uint_as_float(__builtin_amdgcn_readlane(__float_as_uint(gt[1]), it)),
                        g2_ = __uint_as_float(__builtin_amdgcn_readlane(__float_as_uint(gt[2]), it)), g3_ = __uint_as_float(__builtin_amdgcn_readlane(__float_as_uint(gt[3]), it));
            const float gk[4] = {g0 * (1.0f / 16.0f), g1_ * (1.0f / 16.0f), g2_ * (1.0f / 16.0f), g3_ * (1.0f / 16.0f)};
            const float mean1 = __uint_as_float(__builtin_amdgcn_readlane(__float_as_uint(st[0]), it)), rstd1 = __uint_as_float(__builtin_amdgcn_readlane(__float_as_uint(st[1]), it));
            f32x4 v[4]; float s = 0.f;
#pragma unroll
            for (int i = 0; i < 4; ++i) { const unsigned w0 = nz[i >> 1][(i & 1) * 2], w1 = nz[i >> 1][(i & 1) * 2 + 1];
                const f32x4 xin = (f32x4){bflo(w0), bfhi(w0), bflo(w1), bfhi(w1)};
                v[i] = ((xin - mean1) * rstd1) * g1v[i] + b1v[i];
#pragma unroll
                for (int k = 0; k < 4; ++k) { const f32x2 lo = __builtin_amdgcn_cvt_pk_f32_fp8((int)ny[k][i], false), hi = __builtin_amdgcn_cvt_pk_f32_fp8((int)ny[k][i], true);
                    v[i][0] += gk[k] * lo[0]; v[i][1] += gk[k] * lo[1]; v[i][2] += gk[k] * hi[0]; v[i][3] += gk[k] * hi[1]; }
                s += (v[i][0] + v[i][1]) + (v[i][2] + v[i][3]); }
            { const int itn = (it + 1 < nrow) ? it + 1 : it; CMB_LOAD(itn); }
            const float mean = wave_sum_fast(s) * (1.0f / D); float q = 0.f;
#pragma unroll
            for (int i = 0; i < 4; ++i) { v[i] = v[i] - mean; q += (v[i][0] * v[i][0] + v[i][1] * v[i][1]) + (v[i][2] * v[i][2] + v[i][3] * v[i][3]); }
            const float rstd = 1.0f / sqrtf(wave_sum_fast(q) * (1.0f / D) + LN_EPS);
#pragma unroll
            for (int i = 0; i < 4; ++i) v[i] = v[i] * rstd * gv[i] + bv[i];
            if (outf) {
#pragma unroll
                for (int i = 0; i < 4; ++i) *(f32x4*)(outf + (size_t)row * D + 16 * lane + 4 * i) = v[i]; }
            else { u32x4 w0, w1; w0.x = pk2(v[0][0], v[0][1]); w0.y = pk2(v[0][2], v[0][3]); w0.z = pk2(v[1][0], v[1][1]); w0.w = pk2(v[1][2], v[1][3]);
                w1.x = pk2(v[2][0], v[2][1]); w1.y = pk2(v[2][2], v[2][3]); w1.z = pk2(v[3][0], v[3][1]); w1.w = pk2(v[3][2], v[3][3]);
                *(u32x4*)(outb + (size_t)row * D + 16 * lane) = w0; *(u32x4*)(outb + (size_t)row * D + 16 * lane + 8) = w1;
                u32x4 f8; f8.x = pk4_fp8(v[0][0], v[0][1], v[0][2], v[0][3]); f8.y = pk4_fp8(v[1][0], v[1][1], v[1][2], v[1][3]); f8.z = pk4_fp8(v[2][0], v[2][1], v[2][2], v[2][3]); f8.w = pk4_fp8(v[3][0], v[3][1], v[3][2], v[3][3]);
                *(u32x4*)(outf8 + (size_t)row * D + 16 * lane) = f8; }
        }
#undef CMB_LOAD
    }
}

#ifndef PH_MASK
#define PH_MASK 0xFFFFFF
#endif
#ifndef NCONV
#define NCONV 32
#endif
#ifndef DUP_MASK
#define DUP_MASK 0
#endif
#define PH(b) if (PH_MASK & (1u << (b))) for (int rep_ = 0; rep_ < (((DUP_MASK >> (b)) & 1) ? 2 : 1); ++rep_)
#define CAS __attribute__((address_space(4)))
__device__ __forceinline__ const float* arg_ptr(int k) {
    const CAS char* kp = (const CAS char*)__builtin_amdgcn_kernarg_segment_ptr();
    asm volatile("" : "+s"(kp));
    return *(const float* const CAS*)(kp + 8 * k);
}
#define AIN(k) arg_ptr(k)
#define WSP() ((unsigned char*)arg_ptr(23))
#define OUTP() ((float*)arg_ptr(22))

__device__ __forceinline__ int opaque_s(int v) { asm volatile("" : "+s"(v)); return v; }
__device__ __forceinline__ LAS unsigned char* opaque_lds(LAS unsigned char* p) { unsigned v = (unsigned)(size_t)p; asm volatile("" : "+s"(v)); return (LAS unsigned char*)(size_t)v; }
#define PHASE_ENV unsigned char* ws = WSP(); LAS unsigned char* ldsp = opaque_lds((LAS unsigned char*)lds_raw); const int Gp = opaque_s((int)gridDim.x); const int cp = opaque_s((int)blockIdx.x); (void)ws; (void)ldsp; (void)Gp; (void)cp
#define GCNT(ws_, layer_) ((unsigned*)((ws_) + WS_CTL) + 9216 + 64 * (layer_))
#define GRID_BAR() do { XcdBarrier b_; b_.bar = (unsigned*)(WSP() + WS_CTL); b_.x = xb_xcc_id(); b_.st = (volatile LAS unsigned*)(opaque_lds((LAS unsigned char*)lds_raw) + MISC_OFF); xcd_barrier(b_); } while (0)

__global__ void __launch_bounds__(512, 2) fwd_kernel(Args a) {
    extern __shared__ __attribute__((aligned(16))) unsigned char lds_raw[];
    __builtin_amdgcn_s_setreg(1 | (23 << 6), 1);
    { LAS unsigned char* lds0 = (LAS unsigned char*)lds_raw; const int tid0 = threadIdx.x;
      for (int u = tid0; u < (LDS_BYTES - MISC_OFF) / 4; u += 512) ((LAS unsigned*)(lds0 + MISC_OFF))[u] = 0u;
      __syncthreads();
      (void)xcd_barrier_post((unsigned*)(WSP() + WS_CTL), (volatile LAS unsigned*)(lds0 + MISC_OFF)); }

    PH(0) { PHASE_ENV; prologue_phase(ldsp, Gp); }
    GRID_BAR();

    for (int layer = 0; layer < DEPTH; ++layer) {
        const int j = layer >> 1;
        if ((layer & 1) == 0) {
            PH(1) { PHASE_ENV; pg8::TileOrderT<8> S; S.init(T / 256, 8, Gp, cp);
              pg8::SrcDenseT<FP8_IN != 0> X{(const char*)(ws + (FP8_IN ? WS_XF8 : WS_XBF)), (const char*)(ws + WS_WIN) + (size_t)j * 2048 * 1024 * (FP8_IN ? 1 : 2), D, D};
              pg8::EpiIn E{(bf16_t*)(ws + WS_GG), FP8_IN ? (1.0f / 32.0f) : 1.0f};
              pg8::gemm_phase(ldsp, opaque_s(D), S, X, E); }
            GRID_BAR();
            PH(2) { PHASE_ENV; conv_phase((const bf16_t*)(ws + WS_REC), (bf16_t*)(ws + WS_U), AIN(6) + (size_t)j * 4 * D, AIN(7) + (size_t)j * D, Gp); }
            GRID_BAR();
            PH(3) { PHASE_ENV; pg8::TileOrderT<8> S; S.init(T / 256, 8, Gp, cp);
              pg8::SrcGates X{(const char*)(ws + WS_U), (const char*)((bf16_t*)(ws + WS_WGATE) + (size_t)j * 8 * 256 * 128), D};
              pg8::EpiGates E{(bf16_t*)(ws + WS_LA), (bf16_t*)(ws + WS_BB), (const bf16_t*)(ws + WS_U), AIN(9) + (size_t)j * D, AIN(11) + (size_t)j * D, AIN(12) + (size_t)j * D};
              pg8::gemm_phase(ldsp, opaque_s(128), S, X, E); }
            GRID_BAR();
            PH(4) { PHASE_ENV; scan1_phase((const bf16_t*)(ws + WS_LA), (const bf16_t*)(ws + WS_BB), (float*)(ws + WS_AGG), Gp); }
            GRID_BAR();
            PH(4) { PHASE_ENV; scan2_phase((const bf16_t*)(ws + WS_LA), (const bf16_t*)(ws + WS_BB), (const float*)(ws + WS_AGG), (const bf16_t*)(ws + WS_GG), (bf16_t*)(ws + WS_YMIX), Gp); }
            GRID_BAR();
        } else {
            PH(5) { PHASE_ENV; pg8::TileOrderT<12> S; S.init(T / 256, 12, Gp, cp);
              pg8::SrcDenseT<FP8_QKV != 0> X{(const char*)(ws + (FP8_QKV ? WS_XF8 : WS_XBF)), (const char*)(ws + WS_WQKV) + (size_t)j * 3072 * 1024 * (FP8_QKV ? 1 : 2), D, D};
              pg8::EpiQKV E{};
              pg8::gemm_phase(ldsp, opaque_s(D), S, X, E); }
            GRID_BAR();
            PH(7) { PHASE_ENV;
              const moba::Bases BP{(const bf16_t*)(ws + WS_Q), (const bf16_t*)(ws + WS_K), (const bf16_t*)(ws + WS_V), (bf16_t*)(ws + WS_YMIX), (const float*)(ws + WS_KMH)};
              moba::attn_phase((char*)lds_raw, BP, Gp, cp); }
            GRID_BAR();
        }
        PH(8) { PHASE_ENV; pg8::TileOrderT<4> S; S.init(T / 256, 4, Gp, cp);
          pg8::SrcDenseT<FP8_OUT != 0> X{(const char*)(ws + WS_YMIX), (const char*)(ws + WS_WOUT) + (size_t)layer * 1024 * 1024 * (FP8_OUT ? 1 : 2), D, D};
          pg8::EpiOut E{(void*)(ws + WS_Z), (const bf16_t*)(ws + WS_XBF), FP8_OUT ? 1.0f / (32.0f * YMIX_SC) : 1.0f};
          pg8::gemm_phase(ldsp, FP8_OUT ? opaque_s(D) : D, S, X, E); }
        GRID_BAR();
        PH(9) { PHASE_ENV;
          ln1_router_mfma_phase(ldsp, (const bf16_t*)(ws + WS_Z), AIN(1) + (size_t)layer * D, AIN(2) + (size_t)layer * D, AIN(16) + (size_t)layer * D * NE, AIN(17) + (size_t)layer * NE,
                                (float*)(ws + WS_X1BF), (unsigned char*)(ws + WS_X1F8), (float*)(ws + WS_TOKG), GCNT(ws, layer), (int*)(ws + WS_ROWTOK), (int*)(ws + WS_POS), Gp); }
        GRID_BAR();
        const int nconv = (layer + 1 < DEPTH) ? NCONV : 0;
        PH(11) { PHASE_ENV; const int Gg = Gp - opaque_s(nconv);
          if (cp >= Gg) cv_moe_range(ws, ldsp, layer + 1, 0, 32 * 512, Gp - Gg, cp - Gg);
          else { LAS unsigned char* tile_e = ldsp + MISC_TILE_E; const int n_rt = build_tile_e(tile_e, (LAS int*)(ldsp + MISC_TF), GCNT(ws, layer));
          pg8::TileOrderT<8> S; S.init(n_rt, 8, Gg, cp);
          pg8::SrcMoeGather<FP8_GU != 0> X{(const char*)(ws + (FP8_GU ? WS_X1F8 : WS_X1BF)), (const char*)(ws + WS_WGU) + (size_t)layer * NE * 2048 * 1024 * (FP8_GU ? 1 : 2), (const int*)(ws + WS_ROWTOK), tile_e, D, 8, (LAS int*)(ldsp + MISC_TAB), (const LAS int*)(ldsp + MISC_TF)};
          pg8::EpiGU<FP8_GU != 0, FP8_DN != 0> E{(void*)(ws + WS_HBUF), AIN(19) + (size_t)layer * NE * 2048, tile_e, (LAS float*)(ldsp + MISC_BIAS)};
          pg8::gemm_phase(ldsp, opaque_s(D), S, X, E); } }
        GRID_BAR();
        PH(12) { PHASE_ENV; const int Gg = Gp - opaque_s(nconv);
          if (cp >= Gg) cv_moe_range(ws, ldsp, layer + 1, 32 * 512, CV_MOE, Gp - Gg, cp - Gg);
          else { LAS unsigned char* tile_e = ldsp + MISC_TILE_E; const int n_rt = build_tile_e(tile_e, (LAS int*)(ldsp + MISC_TF), GCNT(ws, layer));
          pg8::TileOrderT<4> S; S.init(n_rt, 4, Gg, cp);
          pg8::SrcMoeDense<FP8_DN != 0> X{(const char*)(ws + WS_HBUF), (const char*)(ws + WS_WDN) + (size_t)layer * NE * 1024 * 1024 * (FP8_DN ? 1 : 2), tile_e, D, 4};
          pg8::EpiDown<FP8_DN != 0> E{(void*)(ws + WS_YBUF), AIN(21) + (size_t)layer * NE * D, tile_e, (LAS float*)(ldsp + MISC_BIAS)};
          pg8::gemm_phase(ldsp, opaque_s(D), S, X, E); } }
        GRID_BAR();
        PH(13) { PHASE_ENV;
          if ((layer & 1) == 0) { float* ksz = (float*)(ws + WS_KMH); for (int i = cp * 512 + opaque_tid(); i < 128 * 1024; i += Gp * 512) ksz[i] = 0.f; }
          combine_ln2_phase((const bf16_t*)(ws + WS_X1BF), (const void*)(ws + WS_YBUF), (const int*)(ws + WS_POS), (const float*)(ws + WS_TOKG), AIN(3) + (size_t)layer * D, AIN(4) + (size_t)layer * D,
                            (layer == DEPTH - 1) ? OUTP() : (float*)nullptr, (bf16_t*)(ws + WS_XBF), (unsigned char*)(ws + WS_XF8), Gp, (const bf16_t*)(ws + WS_Z), AIN(1) + (size_t)layer * D, AIN(2) + (size_t)layer * D, ldsp, GCNT(ws, layer)); }
        if (layer != DEPTH - 1) GRID_BAR();
    }
}

extern "C" void kernel_launch(void* const* d_in, const int* in_sizes, int n_in, void* d_out, int out_size, void* d_ws, size_t ws_size, hipStream_t stream) {
    static int grid = 0;
    if (grid == 0) {
        if (n_in != 22 || in_sizes[0] != T * D || out_size != T * D || ws_size < WS_END) { fprintf(stderr, "kernel_launch: unexpected shapes (n_in %d, in0 %d, out %d, ws %zu)\n", n_in, n_in > 0 ? in_sizes[0] : -1, out_size, ws_size); grid = -1; return; }
        int dev = 0, cus = 0, per_cu = 0;
        if (hipGetDevice(&dev) != hipSuccess || hipDeviceGetAttribute(&cus, hipDeviceAttributeMultiprocessorCount, dev) != hipSuccess) { grid = -1; return; }
        if (hipFuncSetAttribute((const void*)fwd_kernel, hipFuncAttributeMaxDynamicSharedMemorySize, LDS_BYTES) != hipSuccess) { fprintf(stderr, "kernel_launch: hipFuncSetAttribute failed\n"); grid = -1; return; }
        if (hipOccupancyMaxActiveBlocksPerMultiprocessor(&per_cu, (const void*)fwd_kernel, 512, LDS_BYTES) != hipSuccess || per_cu < 1) fprintf(stderr, "kernel_launch: occupancy query says %d\n", per_cu);
        (void)hipGetLastError();
        grid = cus;
    }
    if (grid < 0) return;
    if (hipMemsetAsync((char*)d_ws + WS_CTL, 0, CTL_ZERO_BYTES, stream) != hipSuccess) return;
    Args a{};
    for (int i = 0; i < 22; ++i) a.in[i] = (const float*)d_in[i];
    a.out = (float*)d_out; a.ws = (unsigned char*)d_ws;
    hipLaunchKernelGGL(fwd_kernel, dim3(grid), dim3(512), LDS_BYTES, stream, a);
}
```
